# Optimizing an MI355X kernel written in HIP

```python
import math
import jax, jax.numpy as jnp
from jax import lax
import numpy as np

D_MODEL = 1024
BATCH = 8
SEQ = 8192
DEPTH = 1

CHUNK = 64
D_MIX = D_MODEL
D_GMLP = D_MIX // 2
GMLP_GROUPS = 4
GMLP_GROUP_W = D_GMLP // GMLP_GROUPS
SGU_BLOCK = 128
D_DIFF = D_MIX - D_GMLP
DIFF_HEADS = 4
DIFF_QK_DIM = D_DIFF // DIFF_HEADS // 2
DIFF_V_DIM = 2 * DIFF_QK_DIM
Q_BLOCK = 128
REL_BUCKETS = 32
REL_MAX_DIST = 128
N_EXPERTS = 32
TOP_K = 4
D_EXPERT = D_MODEL
SWIGLU_ALPHA = 1.702
SWIGLU_LIMIT = 7.0
MOE_BLOCK = 256
NORM_EPS = 1e-5
NEG_INF = -1e30
D_IN = 2 * D_GMLP + 2 * D_DIFF + DIFF_HEADS * DIFF_V_DIM

kernel_name = 'hybrid_gmlp_diffattn_moe'

F32 = jnp.float32


def rms_norm(x, g):
    xf = x.astype(F32)
    y = xf * lax.rsqrt(jnp.mean(xf * xf, axis=-1, keepdims=True) + NORM_EPS)
    return (y * g.astype(F32)).astype(x.dtype)


def layer_norm(x, g, b):
    xf = x.astype(F32)
    mu = jnp.mean(xf, axis=-1, keepdims=True)
    xc = xf - mu
    y = xc * lax.rsqrt(jnp.mean(xc * xc, axis=-1, keepdims=True) + NORM_EPS)
    return (y * g.astype(F32) + b.astype(F32)).astype(x.dtype)


def rel_bucket(rel):
    nb = REL_BUCKETS // 2
    max_exact = nb // 2
    side = jnp.where(rel > 0, nb, 0)
    n = jnp.abs(rel)
    nf = jnp.maximum(n, 1).astype(F32)
    large = max_exact + (jnp.log(nf / max_exact) / math.log(REL_MAX_DIST / max_exact)
                         * (nb - max_exact)).astype(jnp.int32)
    large = jnp.minimum(large, nb - 1)
    return side + jnp.where(n < max_exact, n, large)


def gmlp_sgu(z, ln_g, ln_b, w_s, b_s):
    B, S = z.shape[0], z.shape[1]
    u, v = jnp.split(z, 2, axis=-1)
    v = layer_norm(v, ln_g, ln_b)
    n_blk = S // SGU_BLOCK
    v = v.reshape(B, n_blk, SGU_BLOCK, GMLP_GROUPS, GMLP_GROUP_W)
    pos = jnp.arange(SGU_BLOCK)
    mask = (pos[None, :] // CHUNK) <= (pos[:, None] // CHUNK)
    w = jnp.where(mask[None], w_s, 0)
    sv = jnp.einsum('gij,bnjgc->bnigc', w, v) + b_s.T[None, None, :, :, None]
    return u * sv.reshape(B, S, D_GMLP)


def diff_attention(q, k, v, rel_table, lam, subln_g, lam_init):
    B, S = q.shape[0], q.shape[1]
    n_blk = S // Q_BLOCK
    scale = DIFF_QK_DIM ** -0.5
    qb = q.reshape(B, n_blk, Q_BLOCK, DIFF_HEADS, 2, DIFF_QK_DIM).transpose(1, 0, 3, 4, 2, 5)
    kt = k.transpose(0, 2, 3, 1, 4)
    vt = v.transpose(0, 2, 1, 3)
    kpos = jnp.arange(S)

    def block(args):
        qblk, bi = args
        qpos = bi * Q_BLOCK + jnp.arange(Q_BLOCK)
        rel = kpos[None, :] - qpos[:, None]
        bias = rel_table[rel_bucket(rel)].astype(F32).transpose(2, 0, 1)
        visible = (kpos[None, :] // CHUNK) <= (qpos[:, None] // CHUNK)
        logits = jnp.einsum('bhmqd,bhmkd->bhmqk', qblk, kt).astype(F32) * scale + bias[None, :, None]
        logits = jnp.where(visible, logits, NEG_INF)
        p = jax.nn.softmax(logits, axis=-1)
        attn = p[:, :, 0] - lam * p[:, :, 1]
        return jnp.einsum('bhqk,bhkd->bhqd', attn.astype(v.dtype), vt)

    o = lax.map(block, (qb, jnp.arange(n_blk)))
    o = o.transpose(1, 0, 3, 2, 4).reshape(B, S, DIFF_HEADS, DIFF_V_DIM)
    o = rms_norm(o, subln_g) * (1.0 - lam_init)
    return o.reshape(B, S, D_DIFF)


def moe(h, router_w, router_b, w1, b1, w2, b2):
    B, S, D = h.shape
    n = B * S
    hf = h.reshape(n, D)
    logits = (hf @ router_w + router_b).astype(F32)
    top_v, top_e = lax.top_k(logits, TOP_K)
    gate = jax.nn.softmax(top_v, axis=-1).astype(h.dtype)
    nk = n * TOP_K
    e_flat = top_e.reshape(nk).astype(jnp.int32)
    tok_flat = jnp.arange(nk, dtype=jnp.int32) // TOP_K
    g_flat = gate.reshape(nk)
    order = jnp.argsort(e_flat)
    e_sorted = e_flat[order]
    counts = jax.ops.segment_sum(jnp.ones((nk,), jnp.int32), e_flat, num_segments=N_EXPERTS)
    starts = jnp.cumsum(counts) - counts
    padded = (counts + MOE_BLOCK - 1) // MOE_BLOCK * MOE_BLOCK
    pad_end = jnp.cumsum(padded)
    pad_start = pad_end - padded
    dest = pad_start[e_sorted] + jnp.arange(nk, dtype=jnp.int32) - starts[e_sorted]
    n_blocks = -(-nk // MOE_BLOCK) + N_EXPERTS
    cap = n_blocks * MOE_BLOCK
    row_tok = jnp.zeros((cap,), jnp.int32).at[dest].set(tok_flat[order])
    row_gate = jnp.zeros((cap,), h.dtype).at[dest].set(g_flat[order])
    block_start = jnp.arange(n_blocks, dtype=jnp.int32) * MOE_BLOCK
    block_exp = jnp.minimum(jnp.sum(pad_end[None, :] <= block_start[:, None], axis=1),
                            N_EXPERTS - 1).astype(jnp.int32)

    def expert_block(args):
        tok, gt, e = args
        a = hf[tok] @ w1[e] + b1[e]
        a_glu = jnp.minimum(a[:, ::2], SWIGLU_LIMIT)
        a_lin = jnp.clip(a[:, 1::2], -SWIGLU_LIMIT, SWIGLU_LIMIT)
        act = a_glu * jax.nn.sigmoid(SWIGLU_ALPHA * a_glu) * (a_lin + 1)
        return (act @ w2[e] + b2[e]) * gt[:, None]

    out = lax.map(expert_block, (row_tok.reshape(n_blocks, MOE_BLOCK),
                                 row_gate.reshape(n_blocks, MOE_BLOCK), block_exp))
    y = jnp.zeros((n, D), h.dtype).at[row_tok].add(out.reshape(cap, D))
    return y.reshape(B, S, D)


def setup_inputs(seed: int = 0) -> dict:
    key = jax.random.key(seed)
    ks = jax.random.split(key, 24)
    nrm = lambda k, shape: jax.random.normal(k, shape, F32)
    L = DEPTH
    return {
        'x': nrm(ks[0], (BATCH, SEQ, D_MODEL)),
        'rel_bias_table': 0.5 * nrm(ks[1], (REL_BUCKETS, DIFF_HEADS)),
        'mix_norm_g': 1.0 + 0.02 * nrm(ks[2], (L, D_MODEL)),
        'w_in': nrm(ks[3], (L, D_MODEL, D_IN)) * D_MODEL ** -0.5,
        'sgu_ln_g': 1.0 + 0.02 * nrm(ks[4], (L, D_GMLP)),
        'sgu_ln_b': 0.02 * nrm(ks[5], (L, D_GMLP)),
        'sgu_w': nrm(ks[6], (L, GMLP_GROUPS, SGU_BLOCK, SGU_BLOCK)) * SGU_BLOCK ** -0.5,
        'sgu_b': 1.0 + 0.1 * nrm(ks[7], (L, GMLP_GROUPS, SGU_BLOCK)),
        'gmlp_out_g': 1.0 + 0.02 * nrm(ks[8], (L, D_GMLP)),
        'lambda_q1': 0.1 * nrm(ks[9], (L, DIFF_QK_DIM)),
        'lambda_k1': 0.1 * nrm(ks[10], (L, DIFF_QK_DIM)),
        'lambda_q2': 0.1 * nrm(ks[11], (L, DIFF_QK_DIM)),
        'lambda_k2': 0.1 * nrm(ks[12], (L, DIFF_QK_DIM)),
        'diff_subln_g': 1.0 + 0.02 * nrm(ks[13], (L, DIFF_V_DIM)),
        'w_out': nrm(ks[14], (L, D_MIX, D_MODEL)) * D_MIX ** -0.5,
        'ffn_norm_g': 1.0 + 0.02 * nrm(ks[15], (L, D_MODEL)),
        'router_w': nrm(ks[16], (L, D_MODEL, N_EXPERTS)) * D_MODEL ** -0.5,
        'router_b': 0.01 * nrm(ks[17], (L, N_EXPERTS)),
        'w_mlp1': nrm(ks[18], (L, N_EXPERTS, D_MODEL, 2 * D_EXPERT)) * D_MODEL ** -0.5,
        'b_mlp1': 0.01 * nrm(ks[19], (L, N_EXPERTS, 2 * D_EXPERT)),
        'w_mlp2': nrm(ks[20], (L, N_EXPERTS, D_EXPERT, D_MODEL)) * D_EXPERT ** -0.5,
        'b_mlp2': 0.01 * nrm(ks[21], (L, N_EXPERTS, D_MODEL)),
        'final_norm_g': 1.0 + 0.02 * nrm(ks[22], (D_MODEL,)),
    }


def reference(x, rel_bias_table, mix_norm_g, w_in, sgu_ln_g, sgu_ln_b, sgu_w, sgu_b, gmlp_out_g,
              lambda_q1, lambda_k1, lambda_q2, lambda_k2, diff_subln_g, w_out, ffn_norm_g,
              router_w, router_b, w_mlp1, b_mlp1, w_mlp2, b_mlp2, final_norm_g):
    B, S = x.shape[0], x.shape[1]
    for l in range(DEPTH):
        h = rms_norm(x, mix_norm_g[l])
        proj = h @ w_in[l]
        z, q, k, v = jnp.split(proj, [2 * D_GMLP, 2 * D_GMLP + D_DIFF, 2 * D_GMLP + 2 * D_DIFF], axis=-1)
        g_out = gmlp_sgu(jax.nn.gelu(z, approximate=False), sgu_ln_g[l], sgu_ln_b[l], sgu_w[l], sgu_b[l])
        g_out = rms_norm(g_out, gmlp_out_g[l])
        lam_init = 0.8 - 0.6 * math.exp(-0.3 * l)
        lam = (jnp.exp(jnp.sum(lambda_q1[l].astype(F32) * lambda_k1[l].astype(F32)))
               - jnp.exp(jnp.sum(lambda_q2[l].astype(F32) * lambda_k2[l].astype(F32))) + lam_init)
        d_out = diff_attention(q.reshape(B, S, DIFF_HEADS, 2, DIFF_QK_DIM),
                               k.reshape(B, S, DIFF_HEADS, 2, DIFF_QK_DIM),
                               v.reshape(B, S, DIFF_HEADS, DIFF_V_DIM),
                               rel_bias_table, lam, diff_subln_g[l], lam_init)
        x = x + jnp.concatenate([g_out, d_out], axis=-1) @ w_out[l]
        x = x + moe(rms_norm(x, ffn_norm_g[l]), router_w[l], router_b[l],
                    w_mlp1[l], b_mlp1[l], w_mlp2[l], b_mlp2[l])
    return rms_norm(x, final_norm_g)
```

```cpp
#include <hip/hip_runtime.h>
#include <cstdio>
#include <cstdint>
#include <type_traits>

#ifndef MK_N_LAUNCHES
#define MK_N_LAUNCHES 1
#endif

#ifndef PROBE_REPEAT
#define PROBE_REPEAT -1
#endif
#ifndef PROBE_MODE
#define PROBE_MODE -1
#endif
#ifndef PROBE_AMODE
#define PROBE_AMODE -1
#endif
#ifndef PG_PEEL
#define PG_PEEL 1
#endif
#ifndef EPI_TWICE
#define EPI_TWICE -1
#endif
#define LAS __attribute__((address_space(3)))
#define GAS __attribute__((address_space(1)))
typedef unsigned short bf16_t;
typedef short bf16x8 __attribute__((ext_vector_type(8)));
typedef short bf16x16 __attribute__((ext_vector_type(16)));
typedef short s16x4 __attribute__((ext_vector_type(4)));
typedef float f32x4 __attribute__((ext_vector_type(4)));
typedef float f32x2 __attribute__((ext_vector_type(2)));
typedef float f32x16 __attribute__((ext_vector_type(16)));
typedef unsigned u32x4 __attribute__((ext_vector_type(4)));
typedef unsigned u32x2 __attribute__((ext_vector_type(2)));
typedef int i32x8 __attribute__((ext_vector_type(8)));
typedef int i32x4 __attribute__((ext_vector_type(4)));

constexpr int NTOK = 65536, DM = 1024, SEQ = 8192, NB = 8, DIN = 2560, NEXP = 32;
constexpr int NSLOTS = NTOK * 4;
constexpr float NORM_EPS = 1e-5f;
constexpr float LOG2E = 1.4426950408889634f;
constexpr float QSCALE = 0.125f * LOG2E;
constexpr int NWAVES = 8, NTHR = 512;

constexpr size_t MiB = 1u << 20;
constexpr size_t WS_CTL = 0, CTL_ZERO_BYTES = 1 * MiB;
constexpr size_t WS_TBL = 1 * MiB;
constexpr size_t WS_WRH = 1 * MiB + 65536;
constexpr size_t WS_WRL = 1 * MiB + 2 * 65536;
constexpr size_t WS_WIN = 2 * MiB;
constexpr size_t WS_WOUT = 7 * MiB;
constexpr size_t WS_SGUW = 9 * MiB;
constexpr size_t WS_TOPE = 10 * MiB;
constexpr size_t WS_TOPG = 11 * MiB;
constexpr size_t WS_LIST = 12 * MiB;
constexpr size_t WS_RSTD = 13 * MiB;
constexpr size_t WS_RSRT = 14 * MiB;
constexpr size_t WS_KMAX = 15 * MiB;
constexpr size_t WS_W1 = 16 * MiB;
constexpr size_t WS_W2 = 80 * MiB;
constexpr size_t WS_H2 = 112 * MiB;
constexpr size_t WS_ACT = 176 * MiB;
constexpr size_t WS_H = 208 * MiB;
constexpr size_t WS_MIX = 208 * MiB;
constexpr size_t WS_U = 336 * MiB;
constexpr size_t WS_Y = 432 * MiB;
constexpr size_t WS_END = 944 * MiB;
constexpr size_t PBUF_STRIDE = 64 * MiB / 2;

constexpr int CW_BAR = 4096;
constexpr int CW_CNT = 16384;
constexpr int CW_CUR = 16384 + 64;

constexpr int LDS_BYTES = 147456;
constexpr int L_TBL = 131072;
constexpr int L_MISC = 135168;
constexpr int L_CTL = 137216;

__device__ __forceinline__ unsigned cvt_pk_bf16(float lo, float hi) { unsigned r; asm volatile("v_cvt_pk_bf16_f32 %0, %1, %2" : "=v"(r) : "v"(lo), "v"(hi)); return r; }
__device__ __forceinline__ unsigned cvt4_fp8(float a, float b, float c, float d) { int r = 0; r = __builtin_amdgcn_cvt_pk_fp8_f32(a, b, r, false); r = __builtin_amdgcn_cvt_pk_fp8_f32(c, d, r, true); return (unsigned)r; }
constexpr float F8_YSCALE = 32.0f;
constexpr float F8_WSCALE = 64.0f, F8_XSCALE = 8.0f, F8_ASCALE = 4.0f;
__device__ __forceinline__ float bf_lo(unsigned w) { return __uint_as_float(w << 16); }
__device__ __forceinline__ float bf_hi(unsigned w) { return __uint_as_float(w & 0xffff0000u); }
__device__ __forceinline__ float wave_sum(float v) {
#pragma unroll
    for (int o = 1; o < 64; o <<= 1) v += __shfl_xor(v, o);
    return v;
}
#define LDS_WAIT() asm volatile("s_waitcnt lgkmcnt(0)" ::: "memory")
#define VM_WAIT() asm volatile("s_waitcnt vmcnt(0)" ::: "memory")

__device__ __forceinline__ f32x2 gelu_pk(f32x2 v) {
    const f32x2 av = __builtin_elementwise_abs(v), d = av * 0.2316418882f + 1.0f;
    f32x2 t; t.x = __builtin_amdgcn_rcpf(d.x); t.y = __builtin_amdgcn_rcpf(d.y);
    f32x2 q = t * 0.5307027145f + (-0.7265760135f); q = q * t + 0.7107068705f; q = q * t + (-0.142248368f); q = q * t + 0.127414796f; q = q * t;
    const f32x2 s = (v * v) * (-0.72134752044f);
    f32x2 e; e.x = __builtin_amdgcn_exp2f(s.x); e.y = __builtin_amdgcn_exp2f(s.y);
    const f32x2 m = v * (q * e), r = v - m;
    f32x2 o; o.x = v.x < 0.f ? m.x : r.x; o.y = v.y < 0.f ? m.y : r.y; return o;
}

#define XB_TMO      128
#define XB_XCNT(j)  (256  + 64 * (j))
#define XB_XSUB(j)  (1280 + 64 * (j))
#define XB_XGEN(j)  (2304 + 64 * (j))
#define XB_TOP      3328
#define XB_TOPGEN   3392
#define XCD_BAR_WORDS 3456
#define XB_SPIN_CAP (1u << 26)
__device__ __forceinline__ unsigned xb_ld(unsigned* p)              { return __hip_atomic_load(p, __ATOMIC_RELAXED, __HIP_MEMORY_SCOPE_AGENT); }
__device__ __forceinline__ unsigned xb_add(unsigned* p, unsigned v) { return __hip_atomic_fetch_add(p, v, __ATOMIC_RELAXED, __HIP_MEMORY_SCOPE_AGENT); }
__device__ __forceinline__ unsigned xb_xcc_id() { return (unsigned)__builtin_amdgcn_s_getreg((3 << 11) | 20) & 0xFu; }
#define XB_SPIN(cond, bar) do { unsigned _sp = 0; while (cond) { __builtin_amdgcn_s_sleep(1); \
    if ((++_sp & 255u) == 0u) { if (xb_ld(&(bar)[XB_TMO])) break; if (_sp > XB_SPIN_CAP) { atomicAdd(&(bar)[XB_TMO], 1u); break; } } } } while (0)
struct XcdBarrier { unsigned* bar; unsigned x; volatile LAS unsigned* st; };
__device__ __forceinline__ XcdBarrier xcd_barrier_post(unsigned* bar, volatile LAS unsigned* st) {
    XcdBarrier b; b.bar = bar; b.x = xb_xcc_id(); b.st = st;
    if (threadIdx.x == 0) (void)xb_add(&bar[XB_XCNT(b.x)], 1u);
    return b;
}
__device__ __forceinline__ void xcd_barrier_complete(unsigned* bar, unsigned x, unsigned& nloc, unsigned& nx) {
    const unsigned G = gridDim.x * gridDim.y * gridDim.z;
    unsigned sum, cnt, mine, sp = 0u;
    for (;;) {
        sum = 0u; cnt = 0u; mine = 0u;
#pragma unroll
        for (unsigned j = 0; j < 16; ++j) { const unsigned c = xb_ld(&bar[XB_XCNT(j)]); sum += c; cnt += (c > 0u) ? 1u : 0u; mine = (j == x) ? c : mine; }
        if (sum == G) break;
        __builtin_amdgcn_s_sleep(1);
        if ((++sp & 255u) == 0u) { if (xb_ld(&bar[XB_TMO])) break; if (sp > XB_SPIN_CAP) { atomicAdd(&bar[XB_TMO], 1u); break; } }
    }
    nloc = mine > 0u ? mine : 1u; nx = cnt > 0u ? cnt : 1u;
}
__device__ __forceinline__ void xcd_barrier(const XcdBarrier& b) {
    asm volatile("s_waitcnt vmcnt(0)" ::: "memory");
    __syncthreads();
    if (threadIdx.x == 0) {
        unsigned* bar = b.bar;
        __builtin_amdgcn_s_waitcnt(0);
        unsigned nloc = b.st[0], nx = b.st[1];
        if (nloc == 0u) { xcd_barrier_complete(bar, b.x, nloc, nx); b.st[0] = nloc; b.st[1] = nx; }
        const unsigned old = xb_add(&bar[XB_XSUB(b.x)], 1u);
        const unsigned gen = old / nloc;
        if (old + 1u == (gen + 1u) * nloc) {
            __builtin_amdgcn_fence(__ATOMIC_RELEASE, "agent");
            asm volatile("s_waitcnt vmcnt(0)" ::: "memory");
            const unsigned og = xb_add(&bar[XB_TOP], 1u);
            const unsigned tg = og / nx;
            if (og + 1u == (tg + 1u) * nx) xb_add(&bar[XB_TOPGEN], 1u);
            else XB_SPIN(xb_ld(&bar[XB_TOPGEN]) == tg, bar);
            __builtin_amdgcn_fence(__ATOMIC_ACQUIRE, "agent");
            xb_add(&bar[XB_XGEN(b.x)], 1u);
            asm volatile("s_waitcnt vmcnt(0)" ::: "memory");
        } else {
            XB_SPIN(xb_ld(&bar[XB_XGEN(b.x)]) == gen, bar);
            __builtin_amdgcn_fence(__ATOMIC_ACQUIRE, "agent");
            asm volatile("s_waitcnt vmcnt(0)" ::: "memory");
        }
    }
    __syncthreads();
}

namespace pg {
__device__ __forceinline__ void glds4s(const void* sbase, unsigned voff, unsigned lds_dst) { unsigned keep;
    asm volatile("s_mov_b32 %0, m0\n\ts_mov_b32 m0, %3\n\ts_nop 0\n\tglobal_load_lds_dword %1, %2\n\ts_mov_b32 m0, %0" : "=&s"(keep) : "v"(voff), "s"(sbase), "s"(lds_dst) : "memory"); }
__device__ __forceinline__ void glds16x2(const void* sbase, unsigned voff0, unsigned voff1, unsigned lds_dst) { unsigned keep;
    asm volatile("s_mov_b32 %0, m0\n\ts_mov_b32 m0, %4\n\ts_nop 0\n\tglobal_load_lds_dwordx4 %1, %3\n\ts_add_u32 m0, m0, 0x2000\n\ts_nop 0\n\tglobal_load_lds_dwordx4 %2, %3\n\ts_mov_b32 m0, %0"
                 : "=&s"(keep) : "v"(voff0), "v"(voff1), "s"(sbase), "s"(lds_dst) : "memory", "scc"); }
constexpr int BM = 256, BK = 64, HALF = 128, HTB = HALF * BK * 2, STAGE_BYTES = 8 * HTB, NXCD = 8, WGM = 8, KD = 1024;
__host__ __device__ __forceinline__ int lds_byte(int r, int c) { const int st = (r >> 4) * 2 + (c >> 5), rr = r & 15, cc = c & 31, ob = rr * 64 + cc * 2; return st * 1024 + (ob ^ (((ob >> 9) & 1) << 5)); }
__host__ __device__ __forceinline__ void stage_rc(int b, int& R, int& C) { const int st = b / 1024, sb = b % 1024, swz = sb ^ (((sb >> 9) & 1) << 5); R = (st >> 1) * 16 + swz / 64; C = (st & 1) * 32 + (swz % 64) / 2; }
__host__ __device__ __forceinline__ int perm32(int rho) { const int n = rho >> 4, i = rho & 15; return 8 * (i >> 2) + 4 * n + (i & 3); }
__host__ __device__ __forceinline__ int perm32g(int rho) { const int n = rho >> 4, i = rho & 15, j = i & 3; return 8 * (i >> 2) + 4 * n + (((j & 1) << 1) | (j >> 1)); }

template <int WG = WGM>
__device__ __forceinline__ bool tile_order(int i, int G, int c, int nM, int nN, int& pm, int& pn) {
    const int nwg = nM * nN; const long L = (long)i * G + c; if (L >= nwg) return false;
    int wgid = (int)L; { const int q = nwg / NXCD, r = nwg % NXCD, xcd = wgid % NXCD, off = wgid / NXCD; wgid = (xcd < r ? xcd * (q + 1) : r * (q + 1) + (xcd - r) * q) + off; }
    const int nig = WG * nN, gid = wgid / nig, fm = gid * WG, gsz = (nM - fm) < WG ? (nM - fm) : WG;
    pm = fm + ((wgid % nig) % gsz); pn = (wgid % nig) / gsz; return true;
}

template <class P, int MODE = 0>
__device__ __forceinline__ void gemm_phase(LAS unsigned char* lds, const P& p) {
    const int tid = threadIdx.x, wid = __builtin_amdgcn_readfirstlane(tid >> 6), lane = tid & 63, wr = wid >> 2, wc = wid & 3, fr = lane & 15, fq = lane >> 4;
    constexpr bool F8 = P::FP8;
    constexpr int K = KD, nt = F8 ? K / 128 : K / BK;
    constexpr int ROWB = F8 ? K : 2 * K;
    int Rr[2], Cc[2]; unsigned voffB[2];
#pragma unroll
    for (int i = 0; i < 2; ++i) { stage_rc(tid * 16 + i * 8192, Rr[i], Cc[i]); const int Rb = P::PERM == 2 ? ((Rr[i] & ~31) + perm32g(Rr[i] & 31)) : P::PERM ? ((Rr[i] & ~31) + perm32(Rr[i] & 31)) : Rr[i]; voffB[i] = (unsigned)(Rb * ROWB + Cc[i] * 2); }
    constexpr size_t kstep = (size_t)(BK * 2);
    constexpr size_t hstep = (size_t)HALF * ROWB;
    const unsigned ldsa = (unsigned)__builtin_amdgcn_readfirstlane((unsigned)(size_t)lds + (unsigned)wid * 1024u);
    const int aoff = lds_byte(wr * 64 + fr, fq * 8), boff = lds_byte(wc * 32 + fr, fq * 8);
    const int aoff8a = lds_byte(wr * 64 + fr, fq * 16), boff8a = lds_byte(wc * 32 + fr, fq * 16); constexpr int aoff8b_d = 16;
#define PG_SA(b, h) (((b) * 2 + (h)) * HTB)
#define PG_SB(b, h) ((4 + (b) * 2 + (h)) * HTB)
#define PG_STAGE_B(bufoff, gbase) do { if constexpr (!(MODE & 2)) glds16x2((gbase), voffB[0], voffB[1], ldsa + (bufoff)); } while (0)
#define PG_STAGE_A(bufoff, gbase, o0, o1) do { if constexpr (!(MODE & 2)) glds16x2((gbase), (o0), (o1), ldsa + (bufoff)); } while (0)
#define PG_LDA(dst, b, h) do { _Pragma("unroll") for (int m = 0; m < 4; ++m) _Pragma("unroll") for (int k = 0; k < 2; ++k) dst[m][k] = *(const LAS bf16x8*)(lds + PG_SA(b, h) + aoff + m * 2048 + k * 1024); } while (0)
#define PG_LDB(dst, b, h) do { _Pragma("unroll") for (int n = 0; n < 2; ++n) _Pragma("unroll") for (int k = 0; k < 2; ++k) dst[n][k] = *(const LAS bf16x8*)(lds + PG_SB(b, h) + boff + n * 2048 + k * 1024); } while (0)
#define PG_LDA8(dst, b, h) do { if constexpr (!(MODE & 4)) _Pragma("unroll") for (int m = 0; m < 4; ++m) { dst[m].lo = *(const LAS i32x4*)(lds + PG_SA(b, h) + aoff8a + m * 2048); dst[m].hi = *(const LAS i32x4*)(lds + PG_SA(b, h) + aoff8a + aoff8b_d + m * 2048); } } while (0)
#define PG_LDB8(dst, b, h) do { if constexpr (!(MODE & 4)) _Pragma("unroll") for (int n = 0; n < 2; ++n) { dst[n].lo = *(const LAS i32x4*)(lds + PG_SB(b, h) + boff8a + n * 2048); dst[n].hi = *(const LAS i32x4*)(lds + PG_SB(b, h) + boff8a + aoff8b_d + n * 2048); } } while (0)
#define PG_MMA(ai, bj, At, Bt) do { __builtin_amdgcn_s_setprio(1); _Pragma("unroll") for (int m = 0; m < 4; ++m) _Pragma("unroll") for (int n = 0; n < 2; ++n) _Pragma("unroll") for (int k = 0; k < 2; ++k) \
        acc[ai][bj][m][n] = __builtin_amdgcn_mfma_f32_16x16x32_bf16(Bt[n][k], At[m][k], acc[ai][bj][m][n], 0, 0, 0); __builtin_amdgcn_s_setprio(0); } while (0)
#define PG_MMA8(ai, bj, At, Bt) do { __builtin_amdgcn_s_setprio(1); if constexpr (!(MODE & 8)) _Pragma("unroll") for (int m = 0; m < 4; ++m) _Pragma("unroll") for (int n = 0; n < 2; ++n) \
        asm volatile("v_mfma_scale_f32_16x16x128_f8f6f4 %0, %1, %2, %0, %3, %3 op_sel_hi:[0,0,0]" : "+v"(acc[ai][bj][m][n]) : "v"(Bt[n]), "v"(At[m]), "v"(one_scale));     \
        __builtin_amdgcn_s_setprio(0); } while (0)
#define PG_MMA8Z(ai, bj, At, Bt) do { __builtin_amdgcn_s_setprio(1); if constexpr (!(MODE & 8)) _Pragma("unroll") for (int m = 0; m < 4; ++m) _Pragma("unroll") for (int n = 0; n < 2; ++n) \
        asm volatile("v_mfma_scale_f32_16x16x128_f8f6f4 %0, %1, %2, 0, %3, %3 op_sel_hi:[0,0,0]" : "=&v"(acc[ai][bj][m][n]) : "v"(Bt[n]), "v"(At[m]), "v"(one_scale)); \
        __builtin_amdgcn_s_setprio(0); } while (0)
#define PG_WAIT_V(n) asm volatile("s_waitcnt vmcnt(" #n ")" ::: "memory")
#define PG_WAIT_L(n) asm volatile("s_waitcnt lgkmcnt(" #n ")" ::: "memory")
#define PG_BAR do { if constexpr (!(MODE & 16)) __builtin_amdgcn_s_barrier(); } while (0)
#define PG_SCHED __builtin_amdgcn_sched_barrier(0)
    typename P::Unit cur, nxt; int ui = 0;
    if (!p.next(0, cur)) return;
    f32x4 acc[2][2][4][2];
#pragma unroll
    for (int a = 0; a < 2; ++a)
#pragma unroll
        for (int b = 0; b < 2; ++b)
#pragma unroll
            for (int m = 0; m < 4; ++m)
#pragma unroll
                for (int n = 0; n < 2; ++n) acc[a][b][m][n] = (f32x4){0.f, 0.f, 0.f, 0.f};
    bf16x8 At[4][2], B0[2][2], B1[2][2];
    i32x8 At8[4], B08[2], B18[2];
    if constexpr (MODE & 4) { _Pragma("unroll") for (int m = 0; m < 4; ++m) { At8[m] = (i32x8){tid, tid * 3, tid * 5, tid * 7, tid * 9, tid * 11, tid * 13, tid * 17} * 0x01010101 + 0x38383838; asm volatile("" : "+v"(At8[m])); }
        _Pragma("unroll") for (int n = 0; n < 2; ++n) { B08[n] = At8[n]; B18[n] = At8[n + 2]; asm volatile("" : "+v"(B08[n])); asm volatile("" : "+v"(B18[n])); } }
    const int one_scale = 0x7f7f7f7f;
    unsigned cvo[4], nvo[4];
    p.a_off(cur, Rr, Cc, cvo);
    if constexpr (P::EPI_TABLE) p.epi_table(cur, 0, wid, lane);
    const char* const Ab = p.a_base();
    const char* cB = p.b_ptr(cur);
    PG_STAGE_B(PG_SB(0, 0), cB); PG_STAGE_B(PG_SB(0, 1), cB + hstep); PG_STAGE_A(PG_SA(0, 0), Ab, cvo[0], cvo[1]); PG_STAGE_A(PG_SA(0, 1), Ab, cvo[2], cvo[3]);
    if (wr == 1) PG_BAR;
    PG_WAIT_V(2); PG_BAR;
    PG_STAGE_B(PG_SB(1, 0), cB + kstep); PG_STAGE_A(PG_SA(1, 0), Ab + kstep, cvo[0], cvo[1]); PG_STAGE_B(PG_SB(1, 1), cB + hstep + kstep);
    PG_WAIT_V(6); PG_BAR;
    for (;;) {
        const bool has_next = p.next(ui + 1, nxt);
        if constexpr (P::PEEL && PG_PEEL) { if (has_next) p.list_dma(nxt, wid, lane); }
        else { if (has_next) p.a_off(nxt, Rr, Cc, nvo); else { nvo[0] = cvo[0]; nvo[1] = cvo[1]; nvo[2] = cvo[2]; nvo[3] = cvo[3]; } }
        const char* nB = has_next ? p.b_ptr(nxt) : cB;
        auto kpair = [&](auto firstc, auto lastc, const int t) __attribute__((always_inline)) {
            const bool last = lastc; constexpr bool first = decltype(firstc)::value;
            const char* a1 = Ab + (size_t)(t + 1) * kstep;
            const char* a2 = last ? Ab : Ab + (size_t)(t + 2) * kstep; const char* b2 = last ? nB : cB + (size_t)(t + 2) * kstep;
            const char* a3 = a2 + kstep; const char* b3 = b2 + kstep;
            const unsigned o0 = last ? nvo[0] : cvo[0], o1 = last ? nvo[1] : cvo[1], o2 = last ? nvo[2] : cvo[2], o3 = last ? nvo[3] : cvo[3];
            if constexpr (F8) {
            PG_LDB8(B08, 0, 0); PG_LDB8(B18, 0, 1); PG_SCHED; PG_LDA8(At8, 0, 0); PG_STAGE_A(PG_SA(1, 1), a1, cvo[2], cvo[3]);
            PG_WAIT_V(8); PG_WAIT_L(0); PG_BAR; if constexpr (first) { PG_MMA8Z(0, 0, At8, B08); PG_MMA8Z(0, 1, At8, B18); } else { PG_MMA8(0, 0, At8, B08); PG_MMA8(0, 1, At8, B18); } PG_BAR; PG_SCHED;
            PG_LDA8(At8, 0, 1); PG_STAGE_B(PG_SB(0, 0), b2); PG_STAGE_B(PG_SB(0, 1), b2 + hstep); PG_STAGE_A(PG_SA(0, 0), a2, o0, o1);
            PG_WAIT_V(8); PG_WAIT_L(0); PG_BAR; if constexpr (first) { PG_MMA8Z(1, 0, At8, B08); PG_MMA8Z(1, 1, At8, B18); } else { PG_MMA8(1, 0, At8, B08); PG_MMA8(1, 1, At8, B18); } PG_BAR; PG_SCHED;
            PG_LDB8(B08, 1, 0); PG_LDB8(B18, 1, 1); PG_SCHED; PG_LDA8(At8, 1, 0); PG_STAGE_A(PG_SA(0, 1), a2, o2, o3);
            PG_WAIT_V(8); PG_WAIT_L(0); PG_BAR; PG_MMA8(0, 0, At8, B08); PG_MMA8(0, 1, At8, B18); PG_BAR; PG_SCHED;
            PG_LDA8(At8, 1, 1); PG_STAGE_B(PG_SB(1, 0), b3); PG_STAGE_B(PG_SB(1, 1), b3 + hstep); PG_STAGE_A(PG_SA(1, 0), a3, o0, o1);
            PG_WAIT_V(8); PG_WAIT_L(0); PG_BAR; PG_MMA8(1, 0, At8, B08); PG_MMA8(1, 1, At8, B18); PG_BAR; PG_SCHED;
            } else {
            PG_LDB(B0, 0, 0); PG_LDB(B1, 0, 1); PG_SCHED; PG_LDA(At, 0, 0); PG_STAGE_A(PG_SA(1, 1), a1, cvo[2], cvo[3]);
            PG_WAIT_V(8); PG_WAIT_L(0); PG_BAR; PG_MMA(0, 0, At, B0); PG_MMA(0, 1, At, B1); PG_BAR; PG_SCHED;
            PG_LDA(At, 0, 1); PG_STAGE_B(PG_SB(0, 0), b2); PG_STAGE_B(PG_SB(0, 1), b2 + hstep); PG_STAGE_A(PG_SA(0, 0), a2, o0, o1);
            PG_WAIT_V(8); PG_WAIT_L(0); PG_BAR; PG_MMA(1, 0, At, B0); PG_MMA(1, 1, At, B1); PG_BAR; PG_SCHED;
            PG_LDB(B0, 1, 0); PG_LDB(B1, 1, 1); PG_SCHED; PG_LDA(At, 1, 0); PG_STAGE_A(PG_SA(0, 1), a2, o2, o3);
            PG_WAIT_V(8); PG_WAIT_L(0); PG_BAR; PG_MMA(0, 0, At, B0); PG_MMA(0, 1, At, B1); PG_BAR; PG_SCHED;
            PG_LDA(At, 1, 1); PG_STAGE_B(PG_SB(1, 0), b3); PG_STAGE_B(PG_SB(1, 1), b3 + hstep); PG_STAGE_A(PG_SA(1, 0), a3, o0, o1);
            PG_WAIT_V(8); PG_WAIT_L(0); PG_BAR; PG_MMA(1, 0, At, B0); PG_MMA(1, 1, At, B1); PG_BAR; PG_SCHED;
        }
        };
        if constexpr (P::PEEL && PG_PEEL) {
            kpair(std::true_type{}, std::false_type{}, 0);
#pragma unroll 1
            for (int t = 2; t < nt - 2; t += 2) kpair(std::false_type{}, std::false_type{}, t);
            if (has_next) p.a_off_lds(nxt, Rr, Cc, nvo); else { nvo[0] = cvo[0]; nvo[1] = cvo[1]; nvo[2] = cvo[2]; nvo[3] = cvo[3]; }
            kpair(std::false_type{}, std::true_type{}, nt - 2);
        } else {
#pragma unroll 1
            for (int t = 0; t < nt; t += 2) kpair(std::false_type{}, t == nt - 2, t);
        }
        if (wr == 0) PG_BAR;
        if constexpr (F8) asm volatile("s_nop 15\n\ts_nop 15" ::: "memory");
        if constexpr (!(MODE & 1)) p.epi(acc, cur, wr, wc, fr, fq, ui & 1);
        else { _Pragma("unroll") for (int a = 0; a < 2; ++a) _Pragma("unroll") for (int b = 0; b < 2; ++b) _Pragma("unroll") for (int m = 0; m < 4; ++m) _Pragma("unroll") for (int n = 0; n < 2; ++n) asm volatile("" :: "v"(acc[a][b][m][n])); }
        if constexpr (P::PH == EPI_TWICE) { asm volatile("" ::: "memory");
#pragma unroll
            for (int a = 0; a < 2; ++a)
#pragma unroll
                for (int b = 0; b < 2; ++b)
#pragma unroll
                    for (int m = 0; m < 4; ++m)
#pragma unroll
                        for (int n = 0; n < 2; ++n) asm volatile("" : "+v"(acc[a][b][m][n]));
            p.epi(acc, cur, wr, wc, fr, fq, ui & 1); }
        if (!has_next) break;
        if constexpr (!(P::PEEL && PG_PEEL)) {
#pragma unroll
        for (int a = 0; a < 2; ++a)
#pragma unroll
            for (int b = 0; b < 2; ++b)
#pragma unroll
                for (int m = 0; m < 4; ++m)
#pragma unroll
                    for (int n = 0; n < 2; ++n) acc[a][b][m][n] = (f32x4){0.f, 0.f, 0.f, 0.f};
        }
        cur = nxt; cB = nB; cvo[0] = nvo[0]; cvo[1] = nvo[1]; cvo[2] = nvo[2]; cvo[3] = nvo[3]; ++ui;
        if constexpr (P::EPI_TABLE) p.epi_table(cur, ui & 1, wid, lane);
        if (wr == 1) PG_BAR;
    }
    PG_WAIT_V(0);
    PG_BAR;
#undef PG_SA
#undef PG_SB
#undef PG_STAGE_A
#undef PG_STAGE_B
#undef PG_LDA
#undef PG_LDB
#undef PG_MMA
#undef PG_MMA8
#undef PG_LDA8
#undef PG_LDB8
#undef PG_WAIT_V
#undef PG_WAIT_L
#undef PG_BAR
#undef PG_SCHED
}
}

struct Args {
    const float* in[23]; float* out; unsigned char* ws; int ph_lo, ph_hi;
};
struct Frame {
    LAS unsigned char* lds; unsigned* ctl; unsigned char* ws;
    int tid, lane, wave, G, bid;
};

template <bool TO_FP8>
__device__ __forceinline__ void p0_transpose_item(const float* W, int K, int N, bf16_t* WT, LAS float* scr, int item, int lane, const float* kscale = nullptr) {
    const int nblk = N / 32, kb = item / nblk, nb = item % nblk, k0 = 64 * kb, n0 = 32 * nb;
#pragma unroll 8
    for (int i = 0; i < 32; ++i) { const int kk = 2 * i + (lane >> 5); scr[kk * 33 + (lane & 31)] = W[(size_t)(k0 + kk) * N + n0 + (lane & 31)]; }
    LDS_WAIT(); asm volatile("" ::: "memory");
    const int c = lane & 7;
    f32x4 g0 = (f32x4){1.f, 1.f, 1.f, 1.f}, g1 = g0;
    if (kscale) { g0 = *(const f32x4*)(kscale + k0 + 8 * c); g1 = *(const f32x4*)(kscale + k0 + 8 * c + 4); }
    if (TO_FP8) { g0 = g0 * F8_WSCALE; g1 = g1 * F8_WSCALE; }
#pragma unroll
    for (int j = 0; j < 4; ++j) { const int n = (lane >> 3) + 8 * j; const LAS float* s = scr + (8 * c) * 33 + n;
        u32x4 o; o.x = cvt_pk_bf16(s[0 * 33] * g0.x, s[1 * 33] * g0.y); o.y = cvt_pk_bf16(s[2 * 33] * g0.z, s[3 * 33] * g0.w); o.z = cvt_pk_bf16(s[4 * 33] * g1.x, s[5 * 33] * g1.y); o.w = cvt_pk_bf16(s[6 * 33] * g1.z, s[7 * 33] * g1.w);
        if (TO_FP8) { u32x2 q; q.x = cvt4_fp8(s[0 * 33] * g0.x, s[1 * 33] * g0.y, s[2 * 33] * g0.z, s[3 * 33] * g0.w); q.y = cvt4_fp8(s[4 * 33] * g1.x, s[5 * 33] * g1.y, s[6 * 33] * g1.z, s[7 * 33] * g1.w);
            *(u32x2*)((unsigned char*)WT + (size_t)(n0 + n) * K + k0 + 8 * c) = q; }
        else *(u32x4*)(WT + (size_t)(n0 + n) * K + k0 + 8 * c) = o; }
    LDS_WAIT(); asm volatile("" ::: "memory");
}

__device__ __forceinline__ int rel_bucket_dev(int rel) {
    const int side = rel > 0 ? 16 : 0; const int n = rel < 0 ? -rel : rel;
    const float nf = (float)(n > 1 ? n : 1);
    int large = 8 + (int)(logf(nf / 8.0f) / 2.772588722239781f * 8.0f);
    large = large < 15 ? large : 15;
    return side + (n < 8 ? n : large);
}

__device__ __forceinline__ void phase0(const Frame& F, const Args& A) {
    LAS float* scr = (LAS float*)(F.lds + F.wave * 16384);
    const int gw = F.bid * NWAVES + F.wave, NGW = F.G * NWAVES;
    const int gt = F.bid * NTHR + F.tid, NGT = F.G * NTHR;
    bf16_t* WinT = (bf16_t*)(F.ws + WS_WIN); bf16_t* WoT = (bf16_t*)(F.ws + WS_WOUT); bf16_t* W1T = (bf16_t*)(F.ws + WS_W1); bf16_t* W2T = (bf16_t*)(F.ws + WS_W2);
    constexpr int I_IN = 16 * 80, I_OUT = 16 * 32, I_1 = 16 * 64, I_2 = 16 * 32;
    constexpr int NITEMS = I_IN + I_OUT + NEXP * I_1 + NEXP * I_2;
    for (int it = gw; it < NITEMS; it += NGW) {
        int r = it;
        if (r < I_IN) { p0_transpose_item<false>(A.in[3], 1024, DIN, WinT, scr, r, F.lane); continue; } r -= I_IN;
        if (r < I_OUT) { p0_transpose_item<false>(A.in[14], 1024, 1024, WoT, scr, r, F.lane); continue; } r -= I_OUT;
        if (r < NEXP * I_1) { const int e = r / I_1; p0_transpose_item<true>(A.in[18] + (size_t)e * 1024 * 2048, 1024, 2048, (bf16_t*)((unsigned char*)W1T + (size_t)e * 2048 * 1024), scr, r % I_1, F.lane, A.in[15]); continue; } r -= NEXP * I_1;
        { const int e = r / I_2; p0_transpose_item<true>(A.in[20] + (size_t)e * 1024 * 1024, 1024, 1024, (bf16_t*)((unsigned char*)W2T + (size_t)e * 1024 * 1024), scr, r % I_2, F.lane); }
    }
    { bf16_t* SW = (bf16_t*)(F.ws + WS_SGUW); const float* w = A.in[6];
      for (int i = gt; i < 4 * 128 * 128 / 2; i += NGT) { const int e0 = 2 * i, ii = (e0 >> 7) & 127, jj = e0 & 127; const bool vis = (jj >> 6) <= (ii >> 6);
          const float a = vis ? w[e0] : 0.f, b = vis ? w[e0 + 1] : 0.f; ((unsigned*)SW)[i] = cvt_pk_bf16(a, b); } }
    { float* tbl = (float*)(F.ws + WS_TBL); const float* rt = A.in[1];
      for (int i = gt; i < 4 * 256; i += NGT) { const int h = i >> 8, idx = i & 255; const int rel = idx - 191; float v = 0.f;
          if (idx < 255) v = (rt[rel_bucket_dev(rel) * 4 + h] - rt[15 * 4 + h]) * LOG2E; tbl[i] = v; } }
    { bf16_t* WH = (bf16_t*)(F.ws + WS_WRH); bf16_t* WL = (bf16_t*)(F.ws + WS_WRL); const float* rw = A.in[16]; const float* g = A.in[15];
      for (int i = gt; i < 32 * 1024; i += NGT) { const int k = i >> 5, e = i & 31; const float v = rw[i] * g[k];
          const unsigned hi = cvt_pk_bf16(v, 0.f) & 0xffffu; const float r = v - bf_lo(hi); const unsigned lo = cvt_pk_bf16(r, 0.f) & 0xffffu;
          WH[e * 1024 + k] = (bf16_t)hi; WL[e * 1024 + k] = (bf16_t)lo; } }
    { bf16_t* H = (bf16_t*)(F.ws + WS_H); const float* x = A.in[0]; const f32x4* gq = (const f32x4*)A.in[2] + F.lane;
      f32x4 gv[4];
#pragma unroll
      for (int j = 0; j < 4; ++j) gv[j] = gq[64 * j];
      for (int m = gw; m < NTOK; m += NGW) {
          const f32x4* xr = (const f32x4*)(x + (size_t)m * DM) + F.lane; f32x4 v[4]; float s = 0.f;
#pragma unroll
          for (int j = 0; j < 4; ++j) { v[j] = xr[64 * j]; s += (v[j].x * v[j].x + v[j].y * v[j].y) + (v[j].z * v[j].z + v[j].w * v[j].w); }
          const float rstd = __builtin_amdgcn_rsqf(wave_sum(s) * (1.f / DM) + NORM_EPS);
          u32x2* o8 = (u32x2*)(H + (size_t)m * DM) + F.lane;
#pragma unroll
          for (int j = 0; j < 4; ++j) { u32x2 w; w.x = cvt_pk_bf16(v[j].x * rstd * gv[j].x, v[j].y * rstd * gv[j].y); w.y = cvt_pk_bf16(v[j].z * rstd * gv[j].z, v[j].w * rstd * gv[j].w); o8[64 * j] = w; }
      } }
}

struct InProj {
    struct Unit { int pm, pn; };
    static constexpr bool PERM = true, FP8 = false, EPI_TABLE = false; static constexpr int PH = 1; static constexpr bool PEEL = false;
    const bf16_t* A; const bf16_t* Bt; bf16_t* O; int G, c;
    __device__ __forceinline__ bool next(int i, Unit& u) const { return pg::tile_order(i, G, c, NTOK / 256, DIN / 256, u.pm, u.pn); }
    __device__ __forceinline__ void a_off(const Unit& u, const int (&R)[2], const int (&C)[2], unsigned (&o)[4]) const {
#pragma unroll
        for (int h = 0; h < 2; ++h)
#pragma unroll
            for (int i = 0; i < 2; ++i) o[h * 2 + i] = (unsigned)((u.pm * 256 + h * 128 + R[i]) * 1024 + C[i]) * 2u;
    }
    __device__ __forceinline__ const char* a_base() const { return (const char*)A; }
    __device__ __forceinline__ const char* b_ptr(const Unit& u) const { return (const char*)(Bt + (size_t)u.pn * 256 * 1024); }
    __device__ __forceinline__ void epi(const f32x4 (&acc)[2][2][4][2], const Unit& u, int wr, int wc, int fr, int fq, int) const {
        const int buf = u.pn >> 1; bf16_t* base = O + (size_t)buf * PBUF_STRIDE;
        const int row0 = u.pm * 256 + wr * 64 + fr, col0 = (u.pn & 1) * 256 + wc * 32 + 8 * fq;
        const bool act = u.pn < 4; const float sc = (buf == 2) ? QSCALE : 1.0f;
#pragma unroll
        for (int ai = 0; ai < 2; ++ai)
#pragma unroll
            for (int m = 0; m < 4; ++m) { const int r = row0 + ai * 128 + m * 16;
#pragma unroll
                for (int bj = 0; bj < 2; ++bj) { f32x4 v0 = acc[ai][bj][m][0], v1 = acc[ai][bj][m][1];
                    if (act) { f32x2 a = gelu_pk((f32x2){v0[0], v0[1]}), b = gelu_pk((f32x2){v0[2], v0[3]}), c2 = gelu_pk((f32x2){v1[0], v1[1]}), d = gelu_pk((f32x2){v1[2], v1[3]});
                        v0 = (f32x4){a.x, a.y, b.x, b.y}; v1 = (f32x4){c2.x, c2.y, d.x, d.y}; }
                    v0 = v0 * sc; v1 = v1 * sc; u32x4 w; w.x = cvt_pk_bf16(v0[0], v0[1]); w.y = cvt_pk_bf16(v0[2], v0[3]); w.z = cvt_pk_bf16(v1[0], v1[1]); w.w = cvt_pk_bf16(v1[2], v1[3]);
                    const int col = col0 + bj * 128;
                    size_t eoff;
                    if (buf < 3) eoff = (size_t)r * 512 + col;
                    else { const int bb = r >> 13, pos = r & 8191, tile = pos >> 6, row = pos & 63, hh = col >> 7;
                        const size_t img = ((size_t)((bb * 4 + hh) * 128 + tile)) * 8192;
                        if (buf == 3) { const int sub = (col >> 5) & 3, gl = (col >> 3) & 3; eoff = img + sub * 2048 + row * 32 + ((gl ^ ((0x78 >> (2 * ((row >> 3) & 3))) & 3)) * 8); }
                        else { const int c = (col >> 4) & 7, hf = (col >> 3) & 1, prow = (row & 0x33) | (((row >> 3) & 1) << 2) | (((row >> 2) & 1) << 3); eoff = img + c * 1024 + prow * 16 + hf * 8; } }
                    *(u32x4*)(base + eoff) = w; } }
    }
};

struct OutProj {
    struct Unit { int pm, pn; };
    static constexpr bool PERM = true, FP8 = false, EPI_TABLE = false; static constexpr int PH = 4; static constexpr bool PEEL = false;
    const bf16_t* A; const bf16_t* Bt; bf16_t* O; int G, c;
    __device__ __forceinline__ bool next(int i, Unit& u) const { return pg::tile_order(i, G, c, NTOK / 256, DM / 256, u.pm, u.pn); }
    __device__ __forceinline__ void a_off(const Unit& u, const int (&R)[2], const int (&C)[2], unsigned (&o)[4]) const {
#pragma unroll
        for (int h = 0; h < 2; ++h)
#pragma unroll
            for (int i = 0; i < 2; ++i) o[h * 2 + i] = (unsigned)((u.pm * 256 + h * 128 + R[i]) * 1024 + C[i]) * 2u;
    }
    __device__ __forceinline__ const char* a_base() const { return (const char*)A; }
    __device__ __forceinline__ const char* b_ptr(const Unit& u) const { return (const char*)(Bt + (size_t)u.pn * 256 * 1024); }
    __device__ __forceinline__ void epi(const f32x4 (&acc)[2][2][4][2], const Unit& u, int wr, int wc, int fr, int fq, int) const {
        const int row0 = u.pm * 256 + wr * 64 + fr, col0 = u.pn * 256 + wc * 32 + 8 * fq;
#pragma unroll
        for (int ai = 0; ai < 2; ++ai)
#pragma unroll
            for (int m = 0; m < 4; ++m) { bf16_t* rowp = O + (size_t)(row0 + ai * 128 + m * 16) * 2048 + col0;
#pragma unroll
                for (int bj = 0; bj < 2; ++bj) { const f32x4 v0 = acc[ai][bj][m][0], v1 = acc[ai][bj][m][1];
                    u32x4 w; w.x = cvt_pk_bf16(v0[0], v0[1]); w.y = cvt_pk_bf16(v0[2], v0[3]); w.z = cvt_pk_bf16(v1[0], v1[1]); w.w = cvt_pk_bf16(v1[2], v1[3]);
                    *(u32x4*)(rowp + bj * 128) = w; } }
    }
};

#ifndef MOE_WGM
#define MOE_WGM 8
#endif
struct MoeUnit { int e, row0, cnt, pn; };
__device__ __forceinline__ bool moe_next(int i, int G, int c, int nN, const LAS int* tp, const LAS int* rs, MoeUnit& u) {
    const int nM = __builtin_amdgcn_readfirstlane(tp[32]); int pm, pn;
    if (!pg::tile_order<MOE_WGM>(i, G, c, nM, nN, pm, pn)) return false;
    const int j = (int)(threadIdx.x & 31u); const int tj = tp[j], rj = rs[j], rj1 = rs[j + 1];
    const int e = __popcll(__ballot((threadIdx.x & 63u) >= 1u && (threadIdx.x & 63u) < 32u && tj <= pm));
    const int tpe = __builtin_amdgcn_readlane(tj, e), rse = __builtin_amdgcn_readlane(rj, e), rse1 = __builtin_amdgcn_readlane(rj1, e);
    u.e = e; u.row0 = rse + (pm - tpe) * 256; const int rem = rse1 - u.row0; u.cnt = rem < 256 ? rem : 256; u.pn = pn;
    return true;
}
struct Moe1 {
    typedef MoeUnit Unit;
    static constexpr int PERM = 2; static constexpr bool FP8 = true, EPI_TABLE = true; static constexpr int PH = 7; static constexpr bool PEEL = true;
    const bf16_t* H2; const bf16_t* W1T; const float* b1; bf16_t* ACT; const int* list; const float* rss; const LAS int* tp; const LAS int* rs; int G, c;
    __device__ __forceinline__ bool next(int i, Unit& u) const { return moe_next(i, G, c, 8, tp, rs, u); }
    __device__ __forceinline__ void a_off(const Unit& u, const int (&R)[2], const int (&C)[2], unsigned (&o)[4]) const {
#pragma unroll
        for (int h = 0; h < 2; ++h)
#pragma unroll
            for (int i = 0; i < 2; ++i) { int r = h * 128 + R[i]; r = r < u.cnt ? r : u.cnt - 1; const int slot = list[u.row0 + r]; o[h * 2 + i] = (unsigned)((slot >> 2) * 1024 + C[i] * 2); }
    }
    __device__ __forceinline__ void list_dma(const Unit& u, int wid, int lane) const {
        if (wid < 4) pg::glds4s(list + u.row0 + 64 * wid, (unsigned)lane * 4u, (unsigned)__builtin_amdgcn_readfirstlane((unsigned)(size_t)tp + 1024 + wid * 256));
    }
    __device__ __forceinline__ void a_off_lds(const Unit& u, const int (&R)[2], const int (&C)[2], unsigned (&o)[4]) const {
        const LAS int* lst = (const LAS int*)((const LAS unsigned char*)tp + 1024);
#pragma unroll
        for (int h = 0; h < 2; ++h)
#pragma unroll
            for (int i = 0; i < 2; ++i) { int r = h * 128 + R[i]; r = r < u.cnt ? r : u.cnt - 1; const int slot = lst[r]; o[h * 2 + i] = (unsigned)((slot >> 2) * 1024 + C[i] * 2); }
    }
    __device__ __forceinline__ void epi_table(const Unit& u, int par, int wid, int lane) const {
        const float* src = wid < 4 ? rss + u.row0 + 64 * wid : b1 + (size_t)u.e * 2048 + u.pn * 256 + 64 * (wid - 4);
        pg::glds4s(src, (unsigned)lane * 4u, (unsigned)__builtin_amdgcn_readfirstlane((unsigned)(size_t)tp - L_MISC + L_TBL + par * 2048 + wid * 256));
    }
    __device__ __forceinline__ const char* a_base() const { return (const char*)H2; }
    __device__ __forceinline__ const char* b_ptr(const Unit& u) const { return (const char*)W1T + ((size_t)u.e * 2048 + (size_t)u.pn * 256) * 1024; }
    __device__ __forceinline__ void epi(const f32x4 (&acc)[2][2][4][2], const Unit& u, int wr, int wc, int fr, int fq, int par) const {
        const int r0 = wr * 64 + fr;
        const LAS float* tb = (const LAS float*)((const LAS unsigned char*)tp - L_MISC + L_TBL + par * 2048);
        f32x4 bv[2][2];
#pragma unroll
        for (int bj = 0; bj < 2; ++bj)
#pragma unroll
            for (int n = 0; n < 2; ++n) { const f32x4 b = *(const LAS f32x4*)(tb + 256 + wc * 32 + 8 * fq + bj * 128 + 4 * n); bv[bj][n] = (f32x4){b.x, b.z, b.y, b.w}; }
#pragma unroll
        for (int ai = 0; ai < 2; ++ai) {
            float rsv[4];
#pragma unroll
            for (int m = 0; m < 4; ++m) rsv[m] = tb[r0 + ai * 128 + m * 16] * (1.0f / (F8_XSCALE * F8_WSCALE));
            const int rs_ = r0 + ai * 128 + fq * 16;
            unsigned char* rowp = (unsigned char*)ACT + (size_t)(u.row0 + rs_) * 1024 + u.pn * 128 + wc * 16;
#pragma unroll
            for (int bj = 0; bj < 2; ++bj) { unsigned w[4];
#pragma unroll
                for (int m = 0; m < 4; ++m) { f32x2 a[2];
#pragma unroll
                    for (int n = 0; n < 2; ++n) { const f32x4 v = acc[ai][bj][m][n] * rsv[m] + bv[bj][n];
                        f32x2 g = (f32x2){fminf(v.x, 7.0f), fminf(v.y, 7.0f)}; const f32x2 l = (f32x2){fminf(fmaxf(v.z, -7.0f), 7.0f), fminf(fmaxf(v.w, -7.0f), 7.0f)};
                        const f32x2 z = g * (-1.702f * LOG2E); f32x2 d = (f32x2){__builtin_amdgcn_exp2f(z.x), __builtin_amdgcn_exp2f(z.y)}; d = d + 1.0f;
                        const f32x2 sg = (f32x2){__builtin_amdgcn_rcpf(d.x), __builtin_amdgcn_rcpf(d.y)};
                        a[n] = (g * sg) * (l * F8_ASCALE + F8_ASCALE); }
                    w[m] = cvt4_fp8(a[0].x, a[0].y, a[1].x, a[1].y); }
                { auto p = __builtin_amdgcn_permlane16_swap(w[0], w[1], false, false); w[0] = p[0]; w[1] = p[1]; }
                { auto p = __builtin_amdgcn_permlane16_swap(w[2], w[3], false, false); w[2] = p[0]; w[3] = p[1]; }
                { auto p = __builtin_amdgcn_permlane32_swap(w[0], w[2], false, false); w[0] = p[0]; w[2] = p[1]; }
                { auto p = __builtin_amdgcn_permlane32_swap(w[1], w[3], false, false); w[1] = p[0]; w[3] = p[1]; }
                if (rs_ < u.cnt) *(u32x4*)(rowp + bj * 64) = (u32x4){w[0], w[1], w[2], w[3]}; } }
    }
};
struct Moe2 {
    typedef MoeUnit Unit;
    static constexpr bool PERM = true, FP8 = true, EPI_TABLE = true; static constexpr int PH = 8; static constexpr bool PEEL = true;
    const bf16_t* ACT; const bf16_t* W2T; const float* b2; bf16_t* Y; const int* list; int slot_base; const LAS int* tp; const LAS int* rs; int G, c;
    __device__ __forceinline__ bool next(int i, Unit& u) const { return moe_next(i, G, c, 4, tp, rs, u); }
    __device__ __forceinline__ void a_off(const Unit& u, const int (&R)[2], const int (&C)[2], unsigned (&o)[4]) const {
#pragma unroll
        for (int h = 0; h < 2; ++h)
#pragma unroll
            for (int i = 0; i < 2; ++i) o[h * 2 + i] = (unsigned)((u.row0 + h * 128 + R[i]) * 1024 + C[i] * 2);
    }
    __device__ __forceinline__ void list_dma(const Unit&, int, int) const {}
    __device__ __forceinline__ void a_off_lds(const Unit& u, const int (&R)[2], const int (&C)[2], unsigned (&o)[4]) const { a_off(u, R, C, o); }
    __device__ __forceinline__ void epi_table(const Unit& u, int par, int wid, int lane) const {
        const void* src = wid < 4 ? (const void*)(list + u.row0 + 64 * wid) : (const void*)(b2 + (size_t)u.e * 1024 + u.pn * 256 + 64 * (wid - 4));
        pg::glds4s(src, (unsigned)lane * 4u, (unsigned)__builtin_amdgcn_readfirstlane((unsigned)(size_t)tp - L_MISC + L_TBL + par * 2048 + wid * 256));
    }
    __device__ __forceinline__ const char* a_base() const { return (const char*)ACT; }
    __device__ __forceinline__ const char* b_ptr(const Unit& u) const { return (const char*)W2T + ((size_t)u.e * 1024 + (size_t)u.pn * 256) * 1024; }
    __device__ __forceinline__ void epi(const f32x4 (&acc)[2][2][4][2], const Unit& u, int wr, int wc, int fr, int fq, int par) const {
        const int r0 = wr * 64 + fr, col0 = u.pn * 256 + wc * 32 + 16 * (fq >> 1);
        const LAS float* tb = (const LAS float*)((const LAS unsigned char*)tp - L_MISC + L_TBL + par * 2048);
        f32x4 bv[2][2];
#pragma unroll
        for (int bj = 0; bj < 2; ++bj) { bv[bj][0] = *(const LAS f32x4*)(tb + 256 + wc * 32 + 8 * fq + bj * 128); bv[bj][1] = *(const LAS f32x4*)(tb + 256 + wc * 32 + 8 * fq + bj * 128 + 4); }
#pragma unroll
        for (int ai = 0; ai < 2; ++ai)
#pragma unroll
            for (int mp = 0; mp < 2; ++mp) { const int r = r0 + ai * 128 + (2 * mp + (fq & 1)) * 16; const bool ok = r < u.cnt;
                const int slot = ok ? (((const LAS int*)tb)[r] - slot_base) : 0;
                unsigned char* rowp = (unsigned char*)Y + (size_t)slot * 1024 + col0;
#pragma unroll
                for (int bj = 0; bj < 2; ++bj) { u32x2 w[2];
#pragma unroll
                    for (int q = 0; q < 2; ++q) { const int m = 2 * mp + q;
                        const f32x4 v0 = acc[ai][bj][m][0] * (1.0f / (F8_ASCALE * F8_WSCALE)) + bv[bj][0], v1 = acc[ai][bj][m][1] * (1.0f / (F8_ASCALE * F8_WSCALE)) + bv[bj][1];
                        w[q].x = cvt4_fp8(v0[0] * F8_YSCALE, v0[1] * F8_YSCALE, v0[2] * F8_YSCALE, v0[3] * F8_YSCALE); w[q].y = cvt4_fp8(v1[0] * F8_YSCALE, v1[1] * F8_YSCALE, v1[2] * F8_YSCALE, v1[3] * F8_YSCALE); }
                    { auto p = __builtin_amdgcn_permlane16_swap(w[0].x, w[1].x, false, false); w[0].x = p[0]; w[1].x = p[1]; }
                    { auto p = __builtin_amdgcn_permlane16_swap(w[0].y, w[1].y, false, false); w[0].y = p[0]; w[1].y = p[1]; }
                    if (ok) *(u32x4*)(rowp + bj * 128) = (u32x4){w[0].x, w[0].y, w[1].x, w[1].y}; } }
    }
};

__device__ __forceinline__ void moe_tables(const Frame& F) {
    LAS int* tp = (LAS int*)(F.lds + L_MISC); LAS int* rs = tp + 64;
    __syncthreads();
    if (F.tid < 64) {
        const int c = F.tid < 32 ? (int)__hip_atomic_load(F.ctl + CW_CNT + F.tid, __ATOMIC_RELAXED, __HIP_MEMORY_SCOPE_AGENT) : 0;
        int t = (c + 255) >> 8, r = c;
#pragma unroll
        for (int o = 1; o < 32; o <<= 1) { const int tu = __shfl_up(t, o), ru = __shfl_up(r, o); if (F.lane >= o) { t += tu; r += ru; } }
        if (F.tid < 32) { tp[F.tid + 1] = t; rs[F.tid + 1] = r; if (F.tid == 0) { tp[0] = 0; rs[0] = 0; } } }
    __syncthreads();
}

__device__ __forceinline__ unsigned off_b(unsigned row, unsigned ch) { return 256u * row + 16u * (ch ^ (((row & 3u) << 2) | ((row >> 2) & 3u))); }
__device__ __forceinline__ s16x4 tr_read(LAS const unsigned char* p) { return __builtin_bit_cast(s16x4, __builtin_amdgcn_ds_read_tr16_b64_v4i16((LAS s16x4*)p)); }
#define RAW_BAR() do { asm volatile("" ::: "memory"); __builtin_amdgcn_s_barrier(); asm volatile("" ::: "memory"); } while (0)

__device__ __forceinline__ void sgu_unit(const Frame& F, const Args& A, int unit, const bf16_t* wrow) {
    const int lane = F.lane, wid = F.wave;
    const size_t tok0 = (size_t)unit * 128;
    const bf16_t* U = (const bf16_t*)(F.ws + WS_U); const bf16_t* VG = U + PBUF_STRIDE; bf16_t* MIX = (bf16_t*)(F.ws + WS_MIX);
    {
        const f32x4* lg = (const f32x4*)A.in[4] + 2 * lane; const f32x4* lb = (const f32x4*)A.in[5] + 2 * lane;
        const f32x4 g0 = lg[0], g1 = lg[1], b0 = lb[0], b1 = lb[1];
        u32x4 raw[16];
#pragma unroll
        for (int i = 0; i < 16; ++i) raw[i] = *((const u32x4*)(VG + (tok0 + wid * 16 + i) * 512) + lane);
#pragma unroll
        for (int i = 0; i < 16; ++i) {
            float v[8]; v[0] = bf_lo(raw[i].x); v[1] = bf_hi(raw[i].x); v[2] = bf_lo(raw[i].y); v[3] = bf_hi(raw[i].y); v[4] = bf_lo(raw[i].z); v[5] = bf_hi(raw[i].z); v[6] = bf_lo(raw[i].w); v[7] = bf_hi(raw[i].w);
            float s = 0.f;
#pragma unroll
            for (int j = 0; j < 8; ++j) s += v[j];
            const float mean = wave_sum(s) * (1.f / 512.f); float q = 0.f;
#pragma unroll
            for (int j = 0; j < 8; ++j) { v[j] -= mean; q += v[j] * v[j]; }
            const float rstd = __builtin_amdgcn_rsqf(wave_sum(q) * (1.f / 512.f) + NORM_EPS);
            u32x4 w;
            w.x = cvt_pk_bf16(v[0] * rstd * g0.x + b0.x, v[1] * rstd * g0.y + b0.y); w.y = cvt_pk_bf16(v[2] * rstd * g0.z + b0.z, v[3] * rstd * g0.w + b0.w);
            w.z = cvt_pk_bf16(v[4] * rstd * g1.x + b1.x, v[5] * rstd * g1.y + b1.y); w.w = cvt_pk_bf16(v[6] * rstd * g1.z + b1.z, v[7] * rstd * g1.w + b1.w);
            const unsigned row = wid * 16 + i;
            *(LAS u32x4*)(F.lds + (lane >> 4) * 32768 + ((lane & 15) >> 2) * 8192 + row * 64 + (lane & 3) * 16) = w;
        }
    }
    __syncthreads();
    u32x4 uraw[16];
#pragma unroll
    for (int r = 0; r < 16; ++r) uraw[r] = *((const u32x4*)(U + (tok0 + wid * 16 + r) * 512) + lane);
    const int gi = wid >> 1, ih = wid & 1, il = lane & 31, hh = lane >> 5;
    f32x16 acc[4][2];
#pragma unroll
    for (int cb = 0; cb < 4; ++cb)
#pragma unroll
        for (int ib = 0; ib < 2; ++ib)
#pragma unroll
            for (int r = 0; r < 16; ++r) acc[cb][ib][r] = 0.f;
    {
        const unsigned blk = (lane >> 4) & 1, q4 = (lane & 15) >> 2, p4 = lane & 3;
        unsigned ia = (unsigned)(size_t)F.lds + gi * 32768 + 64 * (8 * hh + q4) + 32 * blk + 8 * p4; asm volatile("" : "+v"(ia));
        LAS const unsigned char* img = (LAS const unsigned char*)(size_t)ia;
#pragma unroll
        for (int ks = 0; ks < 8; ++ks) {
            if (ks < 4 || ih == 1) {
                bf16x8 wf[2];
#pragma unroll
                for (int ib = 0; ib < 2; ++ib) wf[ib] = *(const bf16x8*)(wrow + ib * 32 * 128 + 16 * ks);
#pragma unroll
                for (int cb = 0; cb < 4; ++cb) {
                    const s16x4 lo = tr_read(img + 8192 * cb + 1024 * ks);
                    const s16x4 hi = tr_read(img + 8192 * cb + 1024 * ks + 256);
                    const bf16x8 af = (bf16x8){lo[0], lo[1], lo[2], lo[3], hi[0], hi[1], hi[2], hi[3]};
#pragma unroll
                    for (int ib = 0; ib < 2; ++ib) acc[cb][ib] = __builtin_amdgcn_mfma_f32_32x32x16_bf16(af, wf[ib], acc[cb][ib], 0, 0, 0);
                }
            }
        }
    }
    constexpr int UP = 1040;
    __syncthreads();
#pragma unroll
    for (int r = 0; r < 16; ++r) *(LAS u32x4*)(F.lds + (wid * 16 + r) * UP + lane * 16) = uraw[r];
    __syncthreads();
    LAS float* stats = (LAS float*)(F.lds + L_MISC);
    const float* bs = A.in[7] + gi * 128;
#pragma unroll
    for (int ib = 0; ib < 2; ++ib) {
        const int i = ih * 64 + ib * 32 + il; const float bsv = bs[i]; float ss = 0.f;
        LAS const unsigned char* up = F.lds + i * UP + (gi * 128 + 4 * hh) * 2;
#pragma unroll
        for (int cb = 0; cb < 4; ++cb)
#pragma unroll
            for (int rr = 0; rr < 4; ++rr) { const u32x2 uw = *(LAS const u32x2*)(up + (cb * 32 + rr * 8) * 2);
                const float u0 = bf_lo(uw.x), u1 = bf_hi(uw.x), u2 = bf_lo(uw.y), u3 = bf_hi(uw.y);
                float a0 = (acc[cb][ib][rr * 4 + 0] + bsv) * u0, a1 = (acc[cb][ib][rr * 4 + 1] + bsv) * u1, a2 = (acc[cb][ib][rr * 4 + 2] + bsv) * u2, a3 = (acc[cb][ib][rr * 4 + 3] + bsv) * u3;
                acc[cb][ib][rr * 4 + 0] = a0; acc[cb][ib][rr * 4 + 1] = a1; acc[cb][ib][rr * 4 + 2] = a2; acc[cb][ib][rr * 4 + 3] = a3;
                ss += (a0 * a0 + a1 * a1) + (a2 * a2 + a3 * a3); }
        ss += __shfl_xor(ss, 32);
        if (hh == 0) stats[i * 4 + gi] = ss;
    }
    __syncthreads();
    const float* og = A.in[8] + gi * 128 + 4 * hh;
#pragma unroll
    for (int ib = 0; ib < 2; ++ib) {
        const int i = ih * 64 + ib * 32 + il; const f32x4 st = *(LAS const f32x4*)(stats + i * 4);
        const float rstd = __builtin_amdgcn_rsqf(((st.x + st.y) + (st.z + st.w)) * (1.f / 512.f) + NORM_EPS);
        LAS unsigned char* op = F.lds + i * UP + (gi * 128 + 4 * hh) * 2;
#pragma unroll
        for (int cb = 0; cb < 4; ++cb)
#pragma unroll
            for (int rr = 0; rr < 4; ++rr) { const f32x4 gg = *(const f32x4*)(og + cb * 32 + rr * 8);
                u32x2 w; w.x = cvt_pk_bf16(acc[cb][ib][rr * 4 + 0] * rstd * gg.x, acc[cb][ib][rr * 4 + 1] * rstd * gg.y); w.y = cvt_pk_bf16(acc[cb][ib][rr * 4 + 2] * rstd * gg.z, acc[cb][ib][rr * 4 + 3] * rstd * gg.w);
                *(LAS u32x2*)(op + (cb * 32 + rr * 8) * 2) = w; }
    }
    __syncthreads();
#pragma unroll
    for (int r = 0; r < 16; ++r) { const int row = wid * 16 + r; *((u32x4*)(MIX + (tok0 + row) * 1024) + lane) = *(LAS const u32x4*)(F.lds + row * UP + lane * 16); }
    __syncthreads();
}

constexpr int AT_SLOT = 16384, AT_K = 0, AT_V = 3 * AT_SLOT;
constexpr float AT_THR = 40.0f;
__device__ __forceinline__ float max3f(float a, float b, float c) { return fmaxf(fmaxf(a, b), c); }
__device__ __forceinline__ void glds16s(const void* sbase, unsigned voff, unsigned lds_dst) { unsigned keep;
    asm volatile("s_mov_b32 %0, m0\n\ts_mov_b32 m0, %3\n\ts_nop 0\n\tglobal_load_lds_dwordx4 %1, %2\n\ts_mov_b32 m0, %0" : "=&s"(keep) : "v"(voff), "s"(sbase), "s"(lds_dst) : "memory"); }
__device__ __forceinline__ void at_stage_y(f32x4 (&s)[2][4], const LAS float* tbl, bool near, int bbase, bool first, float bnd0, float bnd1, f32x4 (&o)[2][9], f32x4 (&negm)[2], bf16x8 (&pf)[2][2]) {
    if (near) {
#pragma unroll
        for (int blk = 0; blk < 4; ++blk)
#pragma unroll
            for (int r = 0; r < 4; ++r) { const float bv = tbl[bbase + 32 * (blk >> 1) + 4 * (blk & 1) + r]; s[0][blk][r] += bv; s[1][blk][r] += bv; }
    }
    if (first || __any(fmaxf(bnd0 + negm[0][0], bnd1 + negm[1][0]) > AT_THR)) {
        float mx[2];
#pragma unroll
        for (int m = 0; m < 2; ++m) {
            float a = max3f(s[m][0][0], s[m][0][1], s[m][0][2]), b = max3f(s[m][0][3], s[m][1][0], s[m][1][1]);
            a = max3f(a, s[m][1][2], s[m][1][3]); b = max3f(b, s[m][2][0], s[m][2][1]); a = max3f(a, s[m][2][2], s[m][2][3]); b = max3f(b, s[m][3][0], s[m][3][1]);
            a = max3f(a, s[m][3][2], s[m][3][3]); a = fmaxf(a, b);
            { auto rr = __builtin_amdgcn_permlane16_swap(__float_as_uint(a), __float_as_uint(a), false, false); a = fmaxf(__uint_as_float(rr[0]), __uint_as_float(rr[1])); }
            { auto rr = __builtin_amdgcn_permlane32_swap(__float_as_uint(a), __float_as_uint(a), false, false); a = fmaxf(__uint_as_float(rr[0]), __uint_as_float(rr[1])); }
            mx[m] = a;
        }
#pragma unroll
        for (int m = 0; m < 2; ++m) { const float d = first ? mx[m] : fmaxf(mx[m], 0.f); const float f = __builtin_amdgcn_exp2f(-d);
#pragma unroll
            for (int c = 0; c < 9; ++c) o[m][c] = o[m][c] * f;
            negm[m] = negm[m] - d;
#pragma unroll
            for (int blk = 0; blk < 4; ++blk) s[m][blk] = s[m][blk] - d; }
    }
#pragma unroll
    for (int m = 0; m < 2; ++m) {
        unsigned pw[8];
#pragma unroll
        for (int blk = 0; blk < 4; ++blk) { const float p0 = __builtin_amdgcn_exp2f(s[m][blk][0]), p1 = __builtin_amdgcn_exp2f(s[m][blk][1]), p2 = __builtin_amdgcn_exp2f(s[m][blk][2]), p3 = __builtin_amdgcn_exp2f(s[m][blk][3]);
            pw[blk * 2] = cvt_pk_bf16(p0, p1); pw[blk * 2 + 1] = cvt_pk_bf16(p2, p3); }
        pf[m][0] = __builtin_bit_cast(bf16x8, (u32x4){pw[0], pw[1], pw[2], pw[3]});
        pf[m][1] = __builtin_bit_cast(bf16x8, (u32x4){pw[4], pw[5], pw[6], pw[7]});
    }
}
template <bool DO_S, bool DO_PV, int AM = 0>
__device__ __forceinline__ void at_stage_x(LAS const unsigned char* Kl, LAS const unsigned char* Vl, const bf16x8 (&qf)[2][2], const f32x4 (&negm)[2], f32x4 (&s)[2][4], const bf16x8 (&pf)[2][2], f32x4 (&o)[2][9]) {
    { unsigned ka = (unsigned)(size_t)Kl; asm volatile("" : "+v"(ka)); Kl = (LAS const unsigned char*)(size_t)ka; }
    { unsigned va = (unsigned)(size_t)Vl; asm volatile("" : "+v"(va)); Vl = (LAS const unsigned char*)(size_t)va; }
    bf16x8 kf[2][4][2]; s16x4 vr[8][2][2];
#define AT_RDV(c) do { _Pragma("unroll") for (int ks_ = 0; ks_ < 2; ++ks_) _Pragma("unroll") for (int t_ = 0; t_ < 2; ++t_) { if constexpr (!(AM & 4)) vr[c][ks_][t_] = tr_read(Vl + 2048 * (c) + 1024 * ks_ + 256 * t_); else { vr[c][ks_][t_] = (s16x4){(short)0x3c11, (short)0xbd22, (short)0x3e33, (short)0xbc44}; asm volatile("" : "+v"(vr[c][ks_][t_])); } } } while (0)
#define AT_PV(c) do { _Pragma("unroll") for (int ks_ = 0; ks_ < 2; ++ks_) { const s16x4 lo_ = vr[c][ks_][0], hi_ = vr[c][ks_][1]; \
        const bf16x8 vf_ = (bf16x8){lo_[0], lo_[1], lo_[2], lo_[3], hi_[0], hi_[1], hi_[2], hi_[3]}; \
        if constexpr (!(AM & 8)) { o[0][c] = __builtin_amdgcn_mfma_f32_16x16x32_bf16(vf_, pf[0][ks_], o[0][c], 0, 0, 0); o[1][c] = __builtin_amdgcn_mfma_f32_16x16x32_bf16(vf_, pf[1][ks_], o[1][c], 0, 0, 0); } else asm volatile("" :: "v"(vf_)); } } while (0)
#define AT_RDK(ds) do { _Pragma("unroll") for (int m_ = 0; m_ < 2; ++m_) _Pragma("unroll") for (int blk_ = 0; blk_ < 4; ++blk_) \
        { if constexpr (!(AM & 4)) kf[m_][blk_][ds] = *(LAS const bf16x8*)(Kl + 4096 * (2 * m_ + (ds)) + 2048 * (blk_ >> 1) + 256 * (blk_ & 1)); else { kf[m_][blk_][ds] = (bf16x8){(short)0x3c11, (short)0xbd22, (short)0x3e33, (short)0xbc44, (short)0x3d55, (short)0xbe66, (short)0x3c77, (short)0xbd88}; asm volatile("" : "+v"(kf[m_][blk_][ds])); } } } while (0)
#define AT_SB() __builtin_amdgcn_sched_barrier(0)
    AT_RDK(0); AT_RDV(0); AT_RDV(1); AT_SB();
    __builtin_amdgcn_s_setprio(1);
    {
        const short one = (short)0x3F80; const bf16x8 vones = (bf16x8){one, one, one, one, one, one, one, one};
#pragma unroll
        for (int ks = 0; ks < 2; ++ks) if constexpr (!(AM & 8)) { o[0][8] = __builtin_amdgcn_mfma_f32_16x16x32_bf16(vones, pf[0][ks], o[0][8], 0, 0, 0); o[1][8] = __builtin_amdgcn_mfma_f32_16x16x32_bf16(vones, pf[1][ks], o[1][8], 0, 0, 0); }
    }
#pragma unroll
    for (int m = 0; m < 2; ++m)
#pragma unroll
        for (int blk = 0; blk < 4; ++blk) { if constexpr (!(AM & 8)) s[m][blk] = __builtin_amdgcn_mfma_f32_16x16x32_bf16(kf[m][blk][0], qf[m][0], negm[m], 0, 0, 0); else asm volatile("" :: "v"(kf[m][blk][0])); }
    AT_SB(); AT_RDK(1); AT_RDV(2); AT_RDV(3); AT_SB();
    AT_PV(0); AT_PV(1); AT_SB();
#pragma unroll
    for (int m = 0; m < 2; ++m)
#pragma unroll
        for (int blk = 0; blk < 4; ++blk) { if constexpr (!(AM & 8)) s[m][blk] = __builtin_amdgcn_mfma_f32_16x16x32_bf16(kf[m][blk][1], qf[m][1], s[m][blk], 0, 0, 0); else asm volatile("" :: "v"(kf[m][blk][1])); }
    AT_SB(); AT_RDV(4); AT_RDV(5); AT_SB();
    AT_PV(2); AT_PV(3); AT_SB();
    AT_RDV(6); AT_RDV(7); AT_SB();
    AT_PV(4); AT_PV(5); AT_SB();
    AT_PV(6); AT_PV(7);
    __builtin_amdgcn_s_setprio(0);
#undef AT_RDK
#undef AT_SB
#undef AT_RDV
#undef AT_PV
}
template <int AM = 0>
__device__ __forceinline__ void attn_unit(const Frame& F, int b, int h, int qb, float lam, const float* subg) {
    int lane = F.lane; asm volatile("" : "+v"(lane));
    const int wid = F.wave, ql = lane & 15, g = lane >> 4, half = wid >> 2;
    const bf16_t* Qb = (const bf16_t*)(F.ws + WS_U) + 2 * PBUF_STRIDE; const bf16_t* Kb = Qb + PBUF_STRIDE; const bf16_t* Vb = Kb + PBUF_STRIDE; bf16_t* MIX = (bf16_t*)(F.ws + WS_MIX);
    const size_t tokb = (size_t)b * SEQ; const int q0 = qb * 128;
    const int cw = 2 * qb + half;
    const int NT = 2 * qb + 2;
    const size_t qtok = tokb + q0 + 16 * wid + ql;
    const char* Kg = (const char*)Kb + ((size_t)(b * 4 + h) * 128) * 16384;
    const char* Vg = (const char*)Vb + ((size_t)(b * 4 + h) * 128) * 16384;
    const unsigned dvo = (2 * wid) * 1024 + lane * 16;
    const unsigned ldsb = (unsigned)(size_t)F.lds + (2 * wid) * 1024;
#define AT_DMA1(Xg, XOFF, t) do { if constexpr (AM & 16) break; const char* _tb = Xg + (size_t)(t) * 16384; const unsigned _sl = (unsigned)((t) % 3) * AT_SLOT; _Pragma("unroll") for (int _j = 0; _j < 2; ++_j) \
        glds16s(_tb + _j * 1024, dvo, (unsigned)__builtin_amdgcn_readfirstlane(ldsb + XOFF + _sl + _j * 1024)); } while (0)
    const float kmv = F.tid < 256 ? ((const float*)(F.ws + WS_KMAX))[(b * 4 + h) * 256 + F.tid] : 0.f;
    AT_DMA1(Kg, AT_K, 0); AT_DMA1(Kg, AT_K, 1); AT_DMA1(Vg, AT_V, 0);
    bf16x8 qf[2][2];
#pragma unroll
    for (int m = 0; m < 2; ++m)
#pragma unroll
        for (int ds = 0; ds < 2; ++ds) qf[m][ds] = *(const bf16x8*)(Qb + qtok * 512 + h * 128 + m * 64 + 32 * ds + 8 * g);
    float qn[2];
#pragma unroll
    for (int m = 0; m < 2; ++m) { float a = 0.f;
#pragma unroll
        for (int ds = 0; ds < 2; ++ds) { const u32x4 w = __builtin_bit_cast(u32x4, qf[m][ds]);
            a += bf_lo(w.x) * bf_lo(w.x) + bf_hi(w.x) * bf_hi(w.x) + bf_lo(w.y) * bf_lo(w.y) + bf_hi(w.y) * bf_hi(w.y) + bf_lo(w.z) * bf_lo(w.z) + bf_hi(w.z) * bf_hi(w.z) + bf_lo(w.w) * bf_lo(w.w) + bf_hi(w.w) * bf_hi(w.w); }
        a += __shfl_xor(a, 16); a += __shfl_xor(a, 32); qn[m] = sqrtf(a) * 1.01f; }
    LAS float* kmx = (LAS float*)(F.lds + L_MISC);
    if (F.tid < 256) kmx[F.tid] = kmv;
    const float bmaxv = ((const LAS float*)(F.lds + L_TBL))[h * 256 + 255];
    f32x4 o[2][9];
#pragma unroll
    for (int m = 0; m < 2; ++m)
#pragma unroll
        for (int c = 0; c < 9; ++c) o[m][c] = (f32x4){0.f, 0.f, 0.f, 0.f};
    f32x4 negm[2] = {(f32x4){0.f, 0.f, 0.f, 0.f}, (f32x4){0.f, 0.f, 0.f, 0.f}};
    f32x4 s[2][4];
    bf16x8 pf[2][2];
#pragma unroll
    for (int m = 0; m < 2; ++m) {
#pragma unroll
        for (int ks = 0; ks < 2; ++ks) { pf[m][ks] = (bf16x8){0, 0, 0, 0, 0, 0, 0, 0}; if constexpr (AM & 1) { pf[m][ks] = (bf16x8){(short)0x3c11, (short)0x3d22, (short)0x3e33, (short)0x3c44, (short)0x3d55, (short)0x3e66, (short)0x3c77, (short)0x3d88}; asm volatile("" : "+v"(pf[m][ks])); } }
#pragma unroll
        for (int blk = 0; blk < 4; ++blk) s[m][blk] = (f32x4){0.f, 0.f, 0.f, 0.f}; }
    const LAS float* tbl = (const LAS float*)(F.lds + L_TBL) + h * 256;
    const int qpos = (16 * wid + ql) & 63;
    const unsigned qh = ql >> 2, p4 = lane & 3u;
    const unsigned kl = 64u * (8u * qh + (ql & 3u)) + 16u * ((unsigned)g ^ ((0x78u >> (2u * qh)) & 3u));
    const unsigned vl = 32u * (qh + 4u * (g & 1) + 16u * (g >> 1)) + 8u * p4;
    asm volatile("" :: "v"(qf[0][0]), "v"(qf[0][1]), "v"(qf[1][0]), "v"(qf[1][1]));
    asm volatile("s_waitcnt vmcnt(0) lgkmcnt(0)" ::: "memory"); RAW_BAR();
#define IT_BEGIN(i) do { if ((i) + 2 <= NT - 1) AT_DMA1(Kg, AT_K, (i) + 2); if ((i) + 1 <= NT - 1) AT_DMA1(Vg, AT_V, (i) + 1); } while (0)
#define IT_END(i) do { if ((i) + 2 <= NT - 1) asm volatile("s_waitcnt vmcnt(4) lgkmcnt(0)" ::: "memory"); else asm volatile("s_waitcnt vmcnt(0) lgkmcnt(0)" ::: "memory"); RAW_BAR(); } while (0)
#define KSL(t) (F.lds + AT_K + ((t) % 3) * AT_SLOT + kl)
#define VSL(t) (F.lds + AT_V + ((t) % 3) * AT_SLOT + vl)
#define ST_Y(t) if constexpr (!(AM & 1)) { const bool nr_ = (t) >= cw - 2; const float ba_ = nr_ ? bmaxv : 0.f; at_stage_y(s, tbl, nr_, 64 * ((t) - cw + 2) + 63 - qpos + 8 * g, (t) == 0, qn[0] * kmx[2 * (t)] + ba_, qn[1] * kmx[2 * (t) + 1] + ba_, o, negm, pf); }
#define ST_X(t) do { const int t_ = (t); if constexpr (!(AM & 2)) if (t_ <= cw) at_stage_x<true, true, AM>(KSL(t_ + 1), VSL(t_ < 0 ? 0 : t_), qf, negm, s, pf, o); } while (0)
    if (half == 0) {
        for (int i = 0; i <= NT; ++i) { ST_X(i - 1); IT_BEGIN(i); if (i <= cw) ST_Y(i); IT_END(i); }
    } else {
        for (int i = 0; i <= NT; ++i) { IT_BEGIN(i); if (i >= 1 && i - 1 <= cw) ST_Y(i - 1); ST_X(i - 1); IT_END(i); }
    }
#undef IT_BEGIN
#undef IT_END
#undef KSL
#undef VSL
#undef ST_Y
#undef ST_X
#undef AT_DMA1
    f32x4 gsub[8];
#pragma unroll
    for (int c = 0; c < 8; ++c) gsub[c] = *(const f32x4*)(subg + 16 * c + 4 * g);
    const float l1 = o[0][8][0], l2 = o[1][8][0];
    const float i1 = __builtin_amdgcn_rcpf(l1), i2 = lam * __builtin_amdgcn_rcpf(l2);
    float ss = 0.f;
#pragma unroll
    for (int c = 0; c < 8; ++c) { o[0][c] = o[0][c] * i1 - o[1][c] * i2; ss += (o[0][c][0] * o[0][c][0] + o[0][c][1] * o[0][c][1]) + (o[0][c][2] * o[0][c][2] + o[0][c][3] * o[0][c][3]); }
    ss += __shfl_xor(ss, 16); ss += __shfl_xor(ss, 32);
    const float rstd = __builtin_amdgcn_rsqf(ss * (1.f / 128.f) + NORM_EPS) * 0.8f;
    bf16_t* op = MIX + qtok * 1024 + 512 + h * 128 + 4 * g;
#pragma unroll
    for (int c = 0; c < 8; ++c) { const f32x4 gg = gsub[c];
        u32x2 w; w.x = cvt_pk_bf16(o[0][c][0] * rstd * gg.x, o[0][c][1] * rstd * gg.y); w.y = cvt_pk_bf16(o[0][c][2] * rstd * gg.z, o[0][c][3] * rstd * gg.w);
        if constexpr (AM == 0) *(u32x2*)(op + 16 * c) = w; else asm volatile("" :: "v"(w)); }
}

__device__ __forceinline__ void key_norm_pass(const Frame& F) {
    const int gw = F.bid * NWAVES + F.wave, NGW = F.G * NWAVES, lane = F.lane;
    const unsigned char* Kimg = (const unsigned char*)((const bf16_t*)(F.ws + WS_U) + 3 * PBUF_STRIDE); float* KM = (float*)(F.ws + WS_KMAX);
    for (int it = gw; it < 32 * 128; it += NGW) {
        const unsigned char* img = Kimg + (size_t)it * 16384 + lane * 64;
#pragma unroll
        for (int m = 0; m < 2; ++m) { float a = 0.f;
#pragma unroll
            for (int ds = 0; ds < 2; ++ds)
#pragma unroll
                for (int c = 0; c < 4; ++c) { const u32x4 w = *(const u32x4*)(img + (2 * m + ds) * 4096 + c * 16);
                    a += bf_lo(w.x) * bf_lo(w.x) + bf_hi(w.x) * bf_hi(w.x) + bf_lo(w.y) * bf_lo(w.y) + bf_hi(w.y) * bf_hi(w.y) + bf_lo(w.z) * bf_lo(w.z) + bf_hi(w.z) * bf_hi(w.z) + bf_lo(w.w) * bf_lo(w.w) + bf_hi(w.w) * bf_hi(w.w); }
#pragma unroll
            for (int o = 1; o < 64; o <<= 1) a = fmaxf(a, __shfl_xor(a, o));
            if (lane == 0) KM[it * 2 + m] = sqrtf(a) * 1.01f; }
    }
}
template <int AM = 0>
__device__ __forceinline__ void phase2(const Frame& F, const Args& A, bool do_sgu, bool do_attn) {
    if (do_sgu) key_norm_pass(F);
#ifndef NO_SGU
    if (do_sgu) {
        const int wid = F.wave, lane = F.lane, gi = wid >> 1, ih = wid & 1;
        const bf16_t* SW = (const bf16_t*)(F.ws + WS_SGUW) + gi * 16384;
        const bf16_t* wrow = SW + (ih * 64 + (lane & 31)) * 128 + 8 * (lane >> 5);
        for (int u = F.bid; u < 512; u += F.G) sgu_unit(F, A, u, wrow);
    }
#endif
#ifndef NO_ATTN
    if (do_attn) {
        LAS float* tbl = (LAS float*)(F.lds + L_TBL); const float* gt = (const float*)(F.ws + WS_TBL);
        for (int i = F.tid; i < 1024; i += NTHR) tbl[i] = gt[i];
        __syncthreads();
        if (F.tid < 4) { float mxb = 0.f; for (int i = 0; i < 255; ++i) mxb = fmaxf(mxb, tbl[F.tid * 256 + i]); tbl[F.tid * 256 + 255] = mxb; }
        float lam;
        { const float a = F.lane < 64 ? A.in[9][F.lane] * A.in[10][F.lane] : 0.f, b2 = A.in[11][F.lane] * A.in[12][F.lane];
          lam = __expf(wave_sum(a)) - __expf(wave_sum(b2)) + 0.2f; }
        __syncthreads();
        const int vcu = (F.G % 8 == 0) ? (F.bid % 8) * (F.G / 8) + F.bid / 8 : F.bid;
        for (int v = vcu; v < 256; v += F.G) {
            const int bh = v >> 3, s = v & 7;
            for (int i = 0; i < 8; ++i) { const int qb = (i & 1) ? (16 * (i >> 1) + 15 - s) : (16 * (i >> 1) + s);
                attn_unit<AM>(F, bh >> 2, bh & 3, 63 - qb, lam, A.in[13]); }
        }
    }
#endif
}

__device__ __forceinline__ unsigned long long shfl_xor_u64(unsigned long long v, int m) { const unsigned lo = __shfl_xor((unsigned)v, m), hi = __shfl_xor((unsigned)(v >> 32), m); return ((unsigned long long)hi << 32) | lo; }
__device__ __forceinline__ void phase4(const Frame& F, const Args& A) {
    const int lane = F.lane, tl = lane & 15, g = lane >> 4;
    { const u32x4* WH = (const u32x4*)(F.ws + WS_WRH);
      for (int i = F.tid; i < 8192; i += NTHR) { const int hl = i >> 12, e = (i >> 7) & 31, c = i & 127; *(LAS u32x4*)(F.lds + hl * 65536 + e * 2048 + ((c ^ (e & 15)) * 16)) = WH[i]; } }
    LAS int* hist = (LAS int*)(F.lds + L_MISC);
    if (F.tid < 32) hist[F.tid] = 0;
    __syncthreads();
    const float* X = A.in[0]; const bf16_t* D = (const bf16_t*)A.out; bf16_t* H2 = (bf16_t*)(F.ws + WS_H2); int* TE = (int*)(F.ws + WS_TOPE); float* TG = (float*)(F.ws + WS_TOPG);
    const float* rb = A.in[17]; float* RS = (float*)(F.ws + WS_RSTD);
    const int gw = F.bid * NWAVES + F.wave, NGW = F.G * NWAVES;
    for (int task = gw; task < NTOK / 16; task += NGW) {
        const int tok = task * 16 + tl;
        const float* xr = X + (size_t)tok * DM + 8 * g;
        const bf16_t* dr = D + (size_t)tok * 2048 + 8 * g;
        bf16_t* dw = (bf16_t*)A.out + (size_t)tok * 2048 + 8 * g;
        unsigned char* hr = (unsigned char*)H2 + (size_t)tok * DM + 8 * g;
        f32x4 acc[2] = {(f32x4){0.f, 0.f, 0.f, 0.f}, (f32x4){0.f, 0.f, 0.f, 0.f}}; float ssq = 0.f;
#pragma unroll 1
        for (int kq = 0; kq < 4; ++kq) {
            u32x2 hbuf[8]; f32x4 xa[8], xb[8]; u32x4 xd[8];
#pragma unroll
            for (int k8 = 0; k8 < 8; ++k8) { const int ks = kq * 8 + k8; xa[k8] = *(const f32x4*)(xr + 32 * ks); xb[k8] = *(const f32x4*)(xr + 32 * ks + 4); xd[k8] = *(const u32x4*)(dr + 32 * ks); }
            __builtin_amdgcn_sched_barrier(0);
#pragma unroll
            for (int k8 = 0; k8 < 8; ++k8) { const int ks = kq * 8 + k8;
                f32x4 a = xa[k8], b = xb[k8];
                a.x += bf_lo(xd[k8].x); a.y += bf_hi(xd[k8].x); a.z += bf_lo(xd[k8].y); a.w += bf_hi(xd[k8].y); b.x += bf_lo(xd[k8].z); b.y += bf_hi(xd[k8].z); b.z += bf_lo(xd[k8].w); b.w += bf_hi(xd[k8].w);
                ssq += (a.x * a.x + a.y * a.y) + (a.z * a.z + a.w * a.w) + (b.x * b.x + b.y * b.y) + (b.z * b.z + b.w * b.w);
                u32x4 hi; hi.x = cvt_pk_bf16(a.x, a.y); hi.y = cvt_pk_bf16(a.z, a.w); hi.z = cvt_pk_bf16(b.x, b.y); hi.w = cvt_pk_bf16(b.z, b.w);
                xd[k8] = hi;
                u32x4 lo; lo.x = cvt_pk_bf16(a.x - bf_lo(hi.x), a.y - bf_hi(hi.x)); lo.y = cvt_pk_bf16(a.z - bf_lo(hi.y), a.w - bf_hi(hi.y));
                lo.z = cvt_pk_bf16(b.x - bf_lo(hi.z), b.y - bf_hi(hi.z)); lo.w = cvt_pk_bf16(b.z - bf_lo(hi.w), b.w - bf_hi(hi.w));
                hbuf[k8] = (u32x2){cvt4_fp8(a.x * F8_XSCALE, a.y * F8_XSCALE, a.z * F8_XSCALE, a.w * F8_XSCALE), cvt4_fp8(b.x * F8_XSCALE, b.y * F8_XSCALE, b.z * F8_XSCALE, b.w * F8_XSCALE)};
                const bf16x8 xh = __builtin_bit_cast(bf16x8, hi), xl = __builtin_bit_cast(bf16x8, lo);
#pragma unroll
                for (int nb = 0; nb < 2; ++nb) { const int e = 16 * nb + tl; const unsigned co = e * 2048 + (((4 * ks + g) ^ (e & 15)) * 16);
                    const bf16x8 wh = *(LAS const bf16x8*)(F.lds + co), wl = *(LAS const bf16x8*)(F.lds + 65536 + co);
                    acc[nb] = __builtin_amdgcn_mfma_f32_16x16x32_bf16(wh, xh, acc[nb], 0, 0, 0);
                    acc[nb] = __builtin_amdgcn_mfma_f32_16x16x32_bf16(wh, xl, acc[nb], 0, 0, 0);
                    acc[nb] = __builtin_amdgcn_mfma_f32_16x16x32_bf16(wl, xh, acc[nb], 0, 0, 0); }
            }
#pragma unroll
            for (int k8 = 0; k8 < 8; ++k8) { *(u32x2*)(hr + 32 * (kq * 8 + k8)) = hbuf[k8]; *(u32x4*)(dw + 32 * (kq * 8 + k8)) = xd[k8]; }
        }
        ssq += __shfl_xor(ssq, 16); ssq += __shfl_xor(ssq, 32);
        const float rstd = __builtin_amdgcn_rsqf(ssq * (1.f / DM) + NORM_EPS);
        unsigned long long key[8];
#pragma unroll
        for (int nb = 0; nb < 2; ++nb)
#pragma unroll
            for (int r = 0; r < 4; ++r) { const int e = 16 * nb + 4 * g + r; const float v = acc[nb][r] * rstd + rb[e];
                unsigned u = __float_as_uint(v); u = (u & 0x80000000u) ? ~u : (u | 0x80000000u); key[nb * 4 + r] = ((unsigned long long)u << 32) | (unsigned)(31 - e); }
        unsigned long long best[4];
#pragma unroll
        for (int rnd = 0; rnd < 4; ++rnd) {
            unsigned long long bk = key[0];
#pragma unroll
            for (int j = 1; j < 8; ++j) bk = key[j] > bk ? key[j] : bk;
            unsigned long long o1 = shfl_xor_u64(bk, 16); bk = o1 > bk ? o1 : bk; o1 = shfl_xor_u64(bk, 32); bk = o1 > bk ? o1 : bk;
            best[rnd] = bk;
#pragma unroll
            for (int j = 0; j < 8; ++j) key[j] = (key[j] == bk) ? 0ull : key[j];
        }
        float tv[4]; int te[4];
#pragma unroll
        for (int j = 0; j < 4; ++j) { unsigned u = (unsigned)(best[j] >> 32); u = (u & 0x80000000u) ? (u & 0x7fffffffu) : ~u; tv[j] = __uint_as_float(u); te[j] = 31 - (int)(best[j] & 0xffffffffu); }
        const float e1 = __expf(tv[1] - tv[0]), e2 = __expf(tv[2] - tv[0]), e3 = __expf(tv[3] - tv[0]); const float inv = 1.0f / (1.0f + e1 + e2 + e3);
        const float gate = (g == 0 ? 1.0f : g == 1 ? e1 : g == 2 ? e2 : e3) * inv; const int ee = g == 0 ? te[0] : g == 1 ? te[1] : g == 2 ? te[2] : te[3];
        TE[tok * 4 + g] = ee; TG[tok * 4 + g] = gate;
        __hip_atomic_fetch_add(&hist[ee], 1, __ATOMIC_RELAXED, __HIP_MEMORY_SCOPE_WORKGROUP);
        if (g == 0) RS[tok] = rstd;
    }
    __syncthreads();
    if (F.tid < 32) { const int c = hist[F.tid]; if (c) atomicAdd(F.ctl + CW_CNT + F.tid, (unsigned)c); }
}

__device__ __forceinline__ void phase5(const Frame& F) {
    LAS int* lc = (LAS int*)(F.lds + L_MISC);
    const int* TE = (const int*)(F.ws + WS_TOPE); int* LIST = (int*)(F.ws + WS_LIST); const float* RS = (const float*)(F.ws + WS_RSTD); float* RSS = (float*)(F.ws + WS_RSRT);
    const int nchunk = NTOK / 256;
    for (int ch = F.bid; ch < nchunk; ch += F.G) {
        __syncthreads();
        if (F.tid < 128) lc[F.tid] = 0;
        __syncthreads();
        const int s0 = ch * 1024 + F.tid, s1 = s0 + 512;
        const int e0 = TE[s0], e1 = TE[s1];
        __hip_atomic_fetch_add(&lc[e0], 1, __ATOMIC_RELAXED, __HIP_MEMORY_SCOPE_WORKGROUP); __hip_atomic_fetch_add(&lc[e1], 1, __ATOMIC_RELAXED, __HIP_MEMORY_SCOPE_WORKGROUP);
        __syncthreads();
        if (F.tid < 64) {
            const int c = F.tid < 32 ? lc[F.tid] : 0;
            const int base = c ? (int)atomicAdd(F.ctl + CW_CUR + F.tid, (unsigned)c) : 0;
            const int n = F.tid < 32 ? (int)__hip_atomic_load(F.ctl + CW_CNT + F.tid, __ATOMIC_RELAXED, __HIP_MEMORY_SCOPE_AGENT) : 0;
            int r = n;
#pragma unroll
            for (int o = 1; o < 32; o <<= 1) { const int ru = __shfl_up(r, o); if (F.lane >= o) r += ru; }
            if (F.tid < 32) { lc[32 + F.tid] = base; lc[64 + F.tid] = r - n; } }
        __syncthreads();
        const int p0 = lc[64 + e0] + lc[32 + e0] + __hip_atomic_fetch_add(&lc[96 + e0], 1, __ATOMIC_RELAXED, __HIP_MEMORY_SCOPE_WORKGROUP);
        LIST[p0] = s0; RSS[p0] = RS[s0 >> 2];
        const int p1 = lc[64 + e1] + lc[32 + e1] + __hip_atomic_fetch_add(&lc[96 + e1], 1, __ATOMIC_RELAXED, __HIP_MEMORY_SCOPE_WORKGROUP);
        LIST[p1] = s1; RSS[p1] = RS[s1 >> 2];
    }
}

__device__ __forceinline__ void phase8(const Frame& F, const Args& A) {
    int lane = F.lane; asm volatile("" : "+v"(lane));
    const int gw = F.bid * NWAVES + F.wave, NGW = F.G * NWAVES;
    const bf16_t* Y = (const bf16_t*)(F.ws + WS_Y); const float* TG = (const float*)(F.ws + WS_TOPG);
    const f32x4* gq = (const f32x4*)A.in[22] + lane;
    f32x4 gv[4];
#pragma unroll
    for (int j = 0; j < 4; ++j) gv[j] = gq[64 * j];
    for (int m = gw; m < NTOK; m += NGW) {
        const int tok = m;
        f32x4* xr = (f32x4*)(A.out + (size_t)tok * DM) + lane;
        const u32x2* dq = (const u32x2*)((const bf16_t*)A.out + (size_t)tok * 2048) + lane;
        const f32x4 gt = *(const f32x4*)(TG + tok * 4);
        f32x4 v[4];
#pragma unroll
        for (int j = 0; j < 4; ++j) { const u32x2 dw = dq[64 * j]; v[j] = (f32x4){bf_lo(dw.x), bf_hi(dw.x), bf_lo(dw.y), bf_hi(dw.y)}; }
#pragma unroll
        for (int k = 0; k < 4; ++k) { const unsigned* yr = (const unsigned*)((const unsigned char*)Y + ((size_t)m * 4 + k) * DM) + lane; const float gk = gt[k] * (1.0f / F8_YSCALE);
#pragma unroll
            for (int j = 0; j < 4; ++j) { const int w = (int)yr[64 * j]; const f32x2 lo = __builtin_amdgcn_cvt_pk_f32_fp8(w, false), hi = __builtin_amdgcn_cvt_pk_f32_fp8(w, true);
                v[j].x += gk * lo.x; v[j].y += gk * lo.y; v[j].z += gk * hi.x; v[j].w += gk * hi.y; } }
        float s = 0.f;
#pragma unroll
        for (int j = 0; j < 4; ++j) s += (v[j].x * v[j].x + v[j].y * v[j].y) + (v[j].z * v[j].z + v[j].w * v[j].w);
        const float rstd = __builtin_amdgcn_rsqf(wave_sum(s) * (1.f / DM) + NORM_EPS);
#pragma unroll
        for (int j = 0; j < 4; ++j) xr[64 * j] = v[j] * rstd * gv[j];
    }
}

constexpr int N_PHASES = 10;
__global__ void __launch_bounds__(NTHR, 2) mk_fwd(Args args) {
    extern __shared__ __attribute__((aligned(16))) unsigned char lds_raw[];
    Frame F;
    F.lds = (LAS unsigned char*)lds_raw; F.ws = args.ws; F.ctl = (unsigned*)(args.ws + WS_CTL);
    F.tid = threadIdx.x; F.lane = F.tid & 63; F.wave = __builtin_amdgcn_readfirstlane(F.tid >> 6); F.G = gridDim.x; F.bid = blockIdx.x;
    if (F.tid < 64) ((LAS unsigned*)(F.lds + L_CTL))[F.tid] = 0u;
    __syncthreads();
    const int lo = args.ph_lo, hi = args.ph_hi;
    XcdBarrier bar; bar.bar = F.ctl + CW_BAR; bar.x = 0; bar.st = (volatile LAS unsigned*)(F.lds + L_CTL);
    if (hi - lo > 1) bar = xcd_barrier_post(F.ctl + CW_BAR, (volatile LAS unsigned*)(F.lds + L_CTL));
#ifdef ONLY_PHASE
#define IN(k) ((k) == ONLY_PHASE && lo <= (k) && (k) < hi)
#else
#define IN(k) (lo <= (k) && (k) < hi)
#endif
#define SEAM(k) do { if (IN(k) && IN((k) + 1)) xcd_barrier(bar); } while (0)

    if (IN(0)) { phase0(F, args); } SEAM(0);
    if (IN(1)) { InProj P{(const bf16_t*)(F.ws + WS_H), (const bf16_t*)(F.ws + WS_WIN), (bf16_t*)(F.ws + WS_U), F.G, F.bid}; pg::gemm_phase<InProj>(F.lds, P); } SEAM(1);
    if (IN(2)) { phase2(F, args, true, false); } SEAM(2);
    if (IN(3)) { phase2(F, args, false, true); } SEAM(3);
    if (IN(4)) { OutProj P{(const bf16_t*)(F.ws + WS_MIX), (const bf16_t*)(F.ws + WS_WOUT), (bf16_t*)args.out, F.G, F.bid}; pg::gemm_phase<OutProj>(F.lds, P); } SEAM(4);
    if (IN(5)) { phase4(F, args); } SEAM(5);
    if (IN(6)) { phase5(F); } SEAM(6);
    if (IN(7)) { moe_tables(F);
        Moe1 P{(const bf16_t*)(F.ws + WS_H2), (const bf16_t*)(F.ws + WS_W1), args.in[19], (bf16_t*)(F.ws + WS_ACT), (const int*)(F.ws + WS_LIST), (const float*)(F.ws + WS_RSRT),
               (const LAS int*)(F.lds + L_MISC), (const LAS int*)(F.lds + L_MISC) + 64, F.G, F.bid};
        pg::gemm_phase<Moe1>(F.lds, P); }
    SEAM(7);
    if (IN(8)) { moe_tables(F);
        Moe2 P{(const bf16_t*)(F.ws + WS_ACT), (const bf16_t*)(F.ws + WS_W2), args.in[21], (bf16_t*)(F.ws + WS_Y), (const int*)(F.ws + WS_LIST), 0,
               (const LAS int*)(F.lds + L_MISC), (const LAS int*)(F.lds + L_MISC) + 64, F.G, F.bid};
        pg::gemm_phase<Moe2>(F.lds, P); }
    SEAM(8);
    if (IN(9)) { phase8(F, args); }
#if PROBE_AMODE >= 0
    if (IN(11)) { phase2<PROBE_AMODE>(F, args, false, true); }
#endif
#if PROBE_MODE >= 0
    if (IN(10)) { moe_tables(F);
        Moe2 P{(const bf16_t*)(F.ws + WS_ACT), (const bf16_t*)(F.ws + WS_W2), args.in[21], (bf16_t*)(F.ws + WS_Y), (const int*)(F.ws + WS_LIST), 0,
               (const LAS int*)(F.lds + L_MISC), (const LAS int*)(F.lds + L_MISC) + 64, F.G, F.bid};
        pg::gemm_phase<Moe2, PROBE_MODE>(F.lds, P); }
#endif
#undef IN
#undef SEAM
}

extern "C" void kernel_launch(void* const* d_in, const int* in_sizes, int n_in, void* d_out, int out_size, void* d_ws, size_t ws_size, hipStream_t stream) {
    static int grid = 0;
    if (grid == 0) {
        if (n_in != 23 || in_sizes[0] != NTOK * DM || out_size != NTOK * DM || ws_size < WS_END) { fprintf(stderr, "kernel_launch: unexpected shapes (n_in %d, ws %zu); nothing launched\n", n_in, ws_size); grid = -1; return; }
        int dev = 0, cus = 0, per_cu = 0;
        if (hipGetDevice(&dev) != hipSuccess || hipDeviceGetAttribute(&cus, hipDeviceAttributeMultiprocessorCount, dev) != hipSuccess) { grid = -1; return; }
        if (hipFuncSetAttribute((const void*)mk_fwd, hipFuncAttributeMaxDynamicSharedMemorySize, LDS_BYTES) != hipSuccess) { fprintf(stderr, "kernel_launch: hipFuncSetAttribute failed\n"); grid = -1; return; }
        if (hipOccupancyMaxActiveBlocksPerMultiprocessor(&per_cu, (const void*)mk_fwd, NTHR, LDS_BYTES) != hipSuccess || per_cu < 1) { fprintf(stderr, "kernel_launch: occupancy query says %d\n", per_cu); }
        (void)hipGetLastError();
        grid = cus;
    }
    if (grid < 0) return;
    (void)hipMemsetAsync((char*)d_ws + WS_CTL, 0, CTL_ZERO_BYTES, stream);
    Args a{};
    for (int i = 0; i < 23; ++i) a.in[i] = (const float*)d_in[i];
    a.out = (float*)d_out; a.ws = (unsigned char*)d_ws;
#if MK_N_LAUNCHES == 1
    a.ph_lo = 0; a.ph_hi = N_PHASES;
    hipLaunchKernelGGL(mk_fwd, dim3(grid), dim3(NTHR), LDS_BYTES, stream, a);
#else
    for (int p = 0; p < N_PHASES; ++p) { a.ph_lo = p; a.ph_hi = p + 1; const int nrep = (p == PROBE_REPEAT) ? 2 : 1;
        for (int r = 0; r < nrep; ++r) hipLaunchKernelGGL(mk_fwd, dim3(grid), dim3(NTHR), LDS_BYTES, stream, a);
#if PROBE_AMODE >= 0
        if (p == 3) { a.ph_lo = 11; a.ph_hi = 12; hipLaunchKernelGGL(mk_fwd, dim3(grid), dim3(NTHR), LDS_BYTES, stream, a); }
#endif
#if PROBE_MODE >= 0
        if (p == 8) { a.ph_lo = 10; a.ph_hi = 11; hipLaunchKernelGGL(mk_fwd, dim3(grid), dim3(NTHR), LDS_BYTES, stream, a); }
#endif
    }
#endif
}
```

```cpp
#include <hip/hip_runtime.h>
#include <cstdio>
#include <cstdint>
#include <type_traits>

#ifndef MK_N_LAUNCHES
#define MK_N_LAUNCHES 1
#endif

#ifndef PROBE_REPEAT
#define PROBE_REPEAT -1
#endif
#ifndef PROBE_MODE
#define PROBE_MODE -1
#endif
#ifndef PROBE_AMODE
#define PROBE_AMODE -1
#endif
#ifndef PG_PEEL
#define PG_PEEL 1
#endif
#ifndef EPI_TWICE
#define EPI_TWICE -1
#endif
#define LAS __attribute__((address_space(3)))
#define GAS __attribute__((address_space(1)))
typedef unsigned short bf16_t;
typedef short bf16x8 __attribute__((ext_vector_type(8)));
typedef short bf16x16 __attribute__((ext_vector_type(16)));
typedef short s16x4 __attribute__((ext_vector_type(4)));
typedef float f32x4 __attribute__((ext_vector_type(4)));
typedef float f32x2 __attribute__((ext_vector_type(2)));
typedef float f32x16 __attribute__((ext_vector_type(16)));
typedef unsigned u32x4 __attribute__((ext_vector_type(4)));
typedef unsigned u32x2 __attribute__((ext_vector_type(2)));
typedef int i32x8 __attribute__((ext_vector_type(8)));
typedef int i32x4 __attribute__((ext_vector_type(4)));

constexpr int NTOK = 65536, DM = 1024, SEQ = 8192, NB = 8, DIN = 2560, NEXP = 32;
constexpr int NSLOTS = NTOK * 4;
constexpr float NORM_EPS = 1e-5f;
constexpr float LOG2E = 1.4426950408889634f;
constexpr float QSCALE = 0.125f * LOG2E;
constexpr int NWAVES = 8, NTHR = 512;

constexpr size_t MiB = 1u << 20;
constexpr size_t WS_CTL = 0, CTL_ZERO_BYTES = 1 * MiB;
constexpr size_t WS_TBL = 1 * MiB;
constexpr size_t WS_WRH = 1 * MiB + 65536;
constexpr size_t WS_WRL = 1 * MiB + 2 * 65536;
constexpr size_t WS_WIN = 2 * MiB;
constexpr size_t WS_WOUT = 7 * MiB;
constexpr size_t WS_SGUW = 9 * MiB;
constexpr size_t WS_TOPE = 10 * MiB;
constexpr size_t WS_TOPG = 11 * MiB;
constexpr size_t WS_LIST = 12 * MiB;
constexpr size_t WS_RSTD = 13 * MiB;
constexpr size_t WS_RSRT = 14 * MiB;
constexpr size_t WS_KMAX = 15 * MiB;
constexpr size_t WS_W1 = 16 * MiB;
constexpr size_t WS_W2 = 80 * MiB;
constexpr size_t WS_H2 = 112 * MiB;
constexpr size_t WS_ACT = 176 * MiB;
constexpr size_t WS_H = 208 * MiB;
constexpr size_t WS_MIX = 208 * MiB;
constexpr size_t WS_U = 336 * MiB;
constexpr size_t WS_Y = 432 * MiB;
constexpr size_t WS_LISTX = 944 * MiB;
constexpr size_t WS_RSSX = 952 * MiB;
constexpr size_t WS_END = 960 * MiB;
constexpr int LCAP = 65536;
constexpr size_t PBUF_STRIDE = 64 * MiB / 2;

constexpr int CW_BAR = 4096;
constexpr int CW_CNT = 16384;
constexpr int CW_CUR = 16384 + 64;

constexpr int LDS_BYTES = 147456;
constexpr int L_TBL = 131072;
constexpr int L_MISC = 135168;
constexpr int L_CTL = 137216;

__device__ __forceinline__ unsigned cvt_pk_bf16(float lo, float hi) { unsigned r; asm volatile("v_cvt_pk_bf16_f32 %0, %1, %2" : "=v"(r) : "v"(lo), "v"(hi)); return r; }
__device__ __forceinline__ unsigned cvt4_fp8(float a, float b, float c, float d) { int r = 0; r = __builtin_amdgcn_cvt_pk_fp8_f32(a, b, r, false); r = __builtin_amdgcn_cvt_pk_fp8_f32(c, d, r, true); return (unsigned)r; }
constexpr float F8_YSCALE = 32.0f;
constexpr float F8_WSCALE = 64.0f, F8_XSCALE = 8.0f, F8_ASCALE = 4.0f;
__device__ __forceinline__ float bf_lo(unsigned w) { return __uint_as_float(w << 16); }
__device__ __forceinline__ float bf_hi(unsigned w) { return __uint_as_float(w & 0xffff0000u); }
__device__ __forceinline__ float wave_sum(float v) {
#pragma unroll
    for (int o = 1; o < 64; o <<= 1) v += __shfl_xor(v, o);
    return v;
}
#define LDS_WAIT() asm volatile("s_waitcnt lgkmcnt(0)" ::: "memory")
#define VM_WAIT() asm volatile("s_waitcnt vmcnt(0)" ::: "memory")

__device__ __forceinline__ f32x2 gelu_pk(f32x2 v) {
    const f32x2 av = __builtin_elementwise_abs(v), d = av * 0.2316418882f + 1.0f;
    f32x2 t; t.x = __builtin_amdgcn_rcpf(d.x); t.y = __builtin_amdgcn_rcpf(d.y);
    f32x2 q = t * 0.5307027145f + (-0.7265760135f); q = q * t + 0.7107068705f; q = q * t + (-0.142248368f); q = q * t + 0.127414796f; q = q * t;
    const f32x2 s = (v * v) * (-0.72134752044f);
    f32x2 e; e.x = __builtin_amdgcn_exp2f(s.x); e.y = __builtin_amdgcn_exp2f(s.y);
    const f32x2 m = v * (q * e), r = v - m;
    f32x2 o; o.x = v.x < 0.f ? m.x : r.x; o.y = v.y < 0.f ? m.y : r.y; return o;
}

#define XB_TMO      128
#define XB_XCNT(j)  (256  + 64 * (j))
#define XB_XSUB(j)  (1280 + 64 * (j))
#define XB_XGEN(j)  (2304 + 64 * (j))
#define XB_TOP      3328
#define XB_TOPGEN   3392
#define XCD_BAR_WORDS 3456
#define XB_SPIN_CAP (1u << 26)
__device__ __forceinline__ unsigned xb_ld(unsigned* p)              { return __hip_atomic_load(p, __ATOMIC_RELAXED, __HIP_MEMORY_SCOPE_AGENT); }
__device__ __forceinline__ unsigned xb_add(unsigned* p, unsigned v) { return __hip_atomic_fetch_add(p, v, __ATOMIC_RELAXED, __HIP_MEMORY_SCOPE_AGENT); }
__device__ __forceinline__ unsigned xb_xcc_id() { return (unsigned)__builtin_amdgcn_s_getreg((3 << 11) | 20) & 0xFu; }
#define XB_SPIN(cond, bar) do { unsigned _sp = 0; while (cond) { __builtin_amdgcn_s_sleep(1); \
    if ((++_sp & 255u) == 0u) { if (xb_ld(&(bar)[XB_TMO])) break; if (_sp > XB_SPIN_CAP) { atomicAdd(&(bar)[XB_TMO], 1u); break; } } } } while (0)
struct XcdBarrier { unsigned* bar; unsigned x; volatile LAS unsigned* st; };
__device__ __forceinline__ XcdBarrier xcd_barrier_post(unsigned* bar, volatile LAS unsigned* st) {
    XcdBarrier b; b.bar = bar; b.x = xb_xcc_id(); b.st = st;
    if (threadIdx.x == 0) (void)xb_add(&bar[XB_XCNT(b.x)], 1u);
    return b;
}
__device__ __forceinline__ void xcd_barrier_complete(unsigned* bar, unsigned x, unsigned& nloc, unsigned& nx) {
    const unsigned G = gridDim.x * gridDim.y * gridDim.z;
    unsigned sum, cnt, mine, sp = 0u;
    for (;;) {
        sum = 0u; cnt = 0u; mine = 0u;
#pragma unroll
        for (unsigned j = 0; j < 16; ++j) { const unsigned c = xb_ld(&bar[XB_XCNT(j)]); sum += c; cnt += (c > 0u) ? 1u : 0u; mine = (j == x) ? c : mine; }
        if (sum == G) break;
        __builtin_amdgcn_s_sleep(1);
        if ((++sp & 255u) == 0u) { if (xb_ld(&bar[XB_TMO])) break; if (sp > XB_SPIN_CAP) { atomicAdd(&bar[XB_TMO], 1u); break; } }
    }
    nloc = mine > 0u ? mine : 1u; nx = cnt > 0u ? cnt : 1u;
}
__device__ __forceinline__ void xcd_barrier(const XcdBarrier& b) {
    asm volatile("s_waitcnt vmcnt(0)" ::: "memory");
    __syncthreads();
    if (threadIdx.x == 0) {
        unsigned* bar = b.bar;
        __builtin_amdgcn_s_waitcnt(0);
        unsigned nloc = b.st[0], nx = b.st[1];
        if (nloc == 0u) { xcd_barrier_complete(bar, b.x, nloc, nx); b.st[0] = nloc; b.st[1] = nx; }
        const unsigned old = xb_add(&bar[XB_XSUB(b.x)], 1u);
        const unsigned gen = old / nloc;
        if (old + 1u == (gen + 1u) * nloc) {
            __builtin_amdgcn_fence(__ATOMIC_RELEASE, "agent");
            asm volatile("s_waitcnt vmcnt(0)" ::: "memory");
            const unsigned og = xb_add(&bar[XB_TOP], 1u);
            const unsigned tg = og / nx;
            if (og + 1u == (tg + 1u) * nx) xb_add(&bar[XB_TOPGEN], 1u);
            else XB_SPIN(xb_ld(&bar[XB_TOPGEN]) == tg, bar);
            __builtin_amdgcn_fence(__ATOMIC_ACQUIRE, "agent");
            xb_add(&bar[XB_XGEN(b.x)], 1u);
            asm volatile("s_waitcnt vmcnt(0)" ::: "memory");
        } else {
            XB_SPIN(xb_ld(&bar[XB_XGEN(b.x)]) == gen, bar);
            __builtin_amdgcn_fence(__ATOMIC_ACQUIRE, "agent");
            asm volatile("s_waitcnt vmcnt(0)" ::: "memory");
        }
    }
    __syncthreads();
}

namespace pg {
__device__ __forceinline__ void glds4s(const void* sbase, unsigned voff, unsigned lds_dst) { unsigned keep;
    asm volatile("s_mov_b32 %0, m0\n\ts_mov_b32 m0, %3\n\ts_nop 3\n\tglobal_load_lds_dword %1, %2\n\ts_mov_b32 m0, %0" : "=&s"(keep) : "v"(voff), "s"(sbase), "s"(lds_dst) : "memory"); }
__device__ __forceinline__ void glds16x2(const void* sbase, unsigned voff0, unsigned voff1, unsigned lds_dst) { unsigned keep;
    asm volatile("s_mov_b32 %0, m0\n\ts_mov_b32 m0, %4\n\ts_nop 3\n\tglobal_load_lds_dwordx4 %1, %3\n\ts_add_u32 m0, m0, 0x2000\n\ts_nop 0\n\tglobal_load_lds_dwordx4 %2, %3\n\ts_mov_b32 m0, %0"
                 : "=&s"(keep) : "v"(voff0), "v"(voff1), "s"(sbase), "s"(lds_dst) : "memory", "scc"); }
constexpr int BM = 256, BK = 64, HALF = 128, HTB = HALF * BK * 2, STAGE_BYTES = 8 * HTB, NXCD = 8, WGM = 8, KD = 1024;
__host__ __device__ __forceinline__ int lds_byte(int r, int c) { const int st = (r >> 4) * 2 + (c >> 5), rr = r & 15, cc = c & 31, ob = rr * 64 + cc * 2; return st * 1024 + (ob ^ (((ob >> 9) & 1) << 5)); }
__host__ __device__ __forceinline__ void stage_rc(int b, int& R, int& C) { const int st = b / 1024, sb = b % 1024, swz = sb ^ (((sb >> 9) & 1) << 5); R = (st >> 1) * 16 + swz / 64; C = (st & 1) * 32 + (swz % 64) / 2; }
__host__ __device__ __forceinline__ int perm32(int rho) { const int n = rho >> 4, i = rho & 15; return 8 * (i >> 2) + 4 * n + (i & 3); }
__host__ __device__ __forceinline__ int perm32g(int rho) { const int n = rho >> 4, i = rho & 15, j = i & 3; return 8 * (i >> 2) + 4 * n + (((j & 1) << 1) | (j >> 1)); }

template <int WG = WGM>
__device__ __forceinline__ bool tile_order(int i, int G, int c, int nM, int nN, int& pm, int& pn) {
    const int nwg = nM * nN; const long L = (long)i * G + c; if (L >= nwg) return false;
    int wgid = (int)L; { const int q = nwg / NXCD, r = nwg % NXCD, xcd = wgid % NXCD, off = wgid / NXCD; wgid = (xcd < r ? xcd * (q + 1) : r * (q + 1) + (xcd - r) * q) + off; }
    const int nig = WG * nN, gid = wgid / nig, fm = gid * WG, gsz = (nM - fm) < WG ? (nM - fm) : WG;
    pm = fm + ((wgid % nig) % gsz); pn = (wgid % nig) / gsz; return true;
}

template <class P, int MODE = 0>
__device__ __forceinline__ void gemm_phase(LAS unsigned char* lds, const P& p) {
    const int tid = threadIdx.x, wid = __builtin_amdgcn_readfirstlane(tid >> 6), lane = tid & 63, wr = wid >> 2, wc = wid & 3, fr = lane & 15, fq = lane >> 4;
    constexpr bool F8 = P::FP8;
    constexpr int K = KD, nt = F8 ? K / 128 : K / BK;
    constexpr int ROWB = F8 ? K : 2 * K;
    int Rr[2], Cc[2]; unsigned voffB[2];
#pragma unroll
    for (int i = 0; i < 2; ++i) { stage_rc(tid * 16 + i * 8192, Rr[i], Cc[i]); const int Rb = P::PERM == 2 ? ((Rr[i] & ~31) + perm32g(Rr[i] & 31)) : P::PERM ? ((Rr[i] & ~31) + perm32(Rr[i] & 31)) : Rr[i]; voffB[i] = (unsigned)(Rb * ROWB + Cc[i] * 2); }
    constexpr size_t kstep = (size_t)(BK * 2);
    constexpr size_t hstep = (size_t)HALF * ROWB;
    const unsigned ldsa = (unsigned)__builtin_amdgcn_readfirstlane((unsigned)(size_t)lds + (unsigned)wid * 1024u);
    const int aoff = lds_byte(wr * 64 + fr, fq * 8), boff = lds_byte(wc * 32 + fr, fq * 8);
    const int aoff8a = lds_byte(wr * 64 + fr, fq * 16), boff8a = lds_byte(wc * 32 + fr, fq * 16); constexpr int aoff8b_d = 16;
#define PG_SA(b, h) (((b) * 2 + (h)) * HTB)
#define PG_SB(b, h) ((4 + (b) * 2 + (h)) * HTB)
#define PG_STAGE_B(bufoff, gbase) do { if constexpr (!(MODE & 2)) glds16x2((gbase), voffB[0], voffB[1], ldsa + (bufoff)); } while (0)
#define PG_STAGE_A(bufoff, gbase, o0, o1) do { if constexpr (!(MODE & 2)) glds16x2((gbase), (o0), (o1), ldsa + (bufoff)); } while (0)
#define PG_LDA(dst, b, h) do { _Pragma("unroll") for (int m = 0; m < 4; ++m) _Pragma("unroll") for (int k = 0; k < 2; ++k) dst[m][k] = *(const LAS bf16x8*)(lds + PG_SA(b, h) + aoff + m * 2048 + k * 1024); } while (0)
#define PG_LDB(dst, b, h) do { _Pragma("unroll") for (int n = 0; n < 2; ++n) _Pragma("unroll") for (int k = 0; k < 2; ++k) dst[n][k] = *(const LAS bf16x8*)(lds + PG_SB(b, h) + boff + n * 2048 + k * 1024); } while (0)
#define PG_LDA8(dst, b, h) do { if constexpr (!(MODE & 4)) _Pragma("unroll") for (int m = 0; m < 4; ++m) { dst[m].lo = *(const LAS i32x4*)(lds + PG_SA(b, h) + aoff8a + m * 2048); dst[m].hi = *(const LAS i32x4*)(lds + PG_SA(b, h) + aoff8a + aoff8b_d + m * 2048); } } while (0)
#define PG_LDB8(dst, b, h) do { if constexpr (!(MODE & 4)) _Pragma("unroll") for (int n = 0; n < 2; ++n) { dst[n].lo = *(const LAS i32x4*)(lds + PG_SB(b, h) + boff8a + n * 2048); dst[n].hi = *(const LAS i32x4*)(lds + PG_SB(b, h) + boff8a + aoff8b_d + n * 2048); } } while (0)
#define PG_MMA(ai, bj, At, Bt) do { __builtin_amdgcn_s_setprio(1); _Pragma("unroll") for (int m = 0; m < 4; ++m) _Pragma("unroll") for (int n = 0; n < 2; ++n) _Pragma("unroll") for (int k = 0; k < 2; ++k) \
        acc[ai][bj][m][n] = __builtin_amdgcn_mfma_f32_16x16x32_bf16(Bt[n][k], At[m][k], acc[ai][bj][m][n], 0, 0, 0); __builtin_amdgcn_s_setprio(0); } while (0)
#define PG_MMA8(ai, bj, At, Bt) do { __builtin_amdgcn_s_setprio(1); if constexpr (!(MODE & 8)) _Pragma("unroll") for (int m = 0; m < 4; ++m) _Pragma("unroll") for (int n = 0; n < 2; ++n) \
        asm volatile("v_mfma_scale_f32_16x16x128_f8f6f4 %0, %1, %2, %0, %3, %3 op_sel_hi:[0,0,0]" : "+v"(acc[ai][bj][m][n]) : "v"(Bt[n]), "v"(At[m]), "v"(one_scale));     \
        __builtin_amdgcn_s_setprio(0); } while (0)
#define PG_MMA8Z(ai, bj, At, Bt) do { __builtin_amdgcn_s_setprio(1); if constexpr (!(MODE & 8)) _Pragma("unroll") for (int m = 0; m < 4; ++m) _Pragma("unroll") for (int n = 0; n < 2; ++n) \
        asm volatile("v_mfma_scale_f32_16x16x128_f8f6f4 %0, %1, %2, 0, %3, %3 op_sel_hi:[0,0,0]" : "=&v"(acc[ai][bj][m][n]) : "v"(Bt[n]), "v"(At[m]), "v"(one_scale)); \
        __builtin_amdgcn_s_setprio(0); } while (0)
#define PG_WAIT_V(n) asm volatile("s_waitcnt vmcnt(" #n ")" ::: "memory")
#define PG_WAIT_L(n) asm volatile("s_waitcnt lgkmcnt(" #n ")" ::: "memory")
#define PG_BAR do { if constexpr (!(MODE & 16)) __builtin_amdgcn_s_barrier(); } while (0)
#define PG_SCHED __builtin_amdgcn_sched_barrier(0)
    typename P::Unit cur, nxt; int ui = 0;
    if (!p.next(0, cur)) return;
    f32x4 acc[2][2][4][2];
#pragma unroll
    for (int a = 0; a < 2; ++a)
#pragma unroll
        for (int b = 0; b < 2; ++b)
#pragma unroll
            for (int m = 0; m < 4; ++m)
#pragma unroll
                for (int n = 0; n < 2; ++n) acc[a][b][m][n] = (f32x4){0.f, 0.f, 0.f, 0.f};
    bf16x8 At[4][2], B0[2][2], B1[2][2];
    i32x8 At8[4], B08[2], B18[2];
    if constexpr (MODE & 4) { _Pragma("unroll") for (int m = 0; m < 4; ++m) { At8[m] = (i32x8){tid, tid * 3, tid * 5, tid * 7, tid * 9, tid * 11, tid * 13, tid * 17} * 0x01010101 + 0x38383838; asm volatile("" : "+v"(At8[m])); }
        _Pragma("unroll") for (int n = 0; n < 2; ++n) { B08[n] = At8[n]; B18[n] = At8[n + 2]; asm volatile("" : "+v"(B08[n])); asm volatile("" : "+v"(B18[n])); } }
    const int one_scale = 0x7f7f7f7f;
    unsigned cvo[4], nvo[4];
    p.a_off(cur, Rr, Cc, cvo);
    if constexpr (P::EPI_TABLE) p.epi_table(cur, 0, wid, lane);
    const char* const Ab = p.a_base();
    const char* cB = p.b_ptr(cur);
    PG_STAGE_B(PG_SB(0, 0), cB); PG_STAGE_B(PG_SB(0, 1), cB + hstep); PG_STAGE_A(PG_SA(0, 0), Ab, cvo[0], cvo[1]); PG_STAGE_A(PG_SA(0, 1), Ab, cvo[2], cvo[3]);
    if (wr == 1) PG_BAR;
    PG_WAIT_V(2); PG_BAR;
    PG_STAGE_B(PG_SB(1, 0), cB + kstep); PG_STAGE_A(PG_SA(1, 0), Ab + kstep, cvo[0], cvo[1]); PG_STAGE_B(PG_SB(1, 1), cB + hstep + kstep);
    PG_WAIT_V(6); PG_BAR;
    for (;;) {
        const bool has_next = p.next(ui + 1, nxt);
        if constexpr (P::PEEL && PG_PEEL) { if (has_next) p.list_dma(nxt, wid, lane); }
        else { if (has_next) p.a_off(nxt, Rr, Cc, nvo); else { nvo[0] = cvo[0]; nvo[1] = cvo[1]; nvo[2] = cvo[2]; nvo[3] = cvo[3]; } }
        const char* nB = has_next ? p.b_ptr(nxt) : cB;
        auto kpair = [&](auto firstc, auto lastc, const int t) __attribute__((always_inline)) {
            const bool last = lastc; constexpr bool first = decltype(firstc)::value;
            const char* a1 = Ab + (size_t)(t + 1) * kstep;
            const char* a2 = last ? Ab : Ab + (size_t)(t + 2) * kstep; const char* b2 = last ? nB : cB + (size_t)(t + 2) * kstep;
            const char* a3 = a2 + kstep; const char* b3 = b2 + kstep;
            const unsigned o0 = last ? nvo[0] : cvo[0], o1 = last ? nvo[1] : cvo[1], o2 = last ? nvo[2] : cvo[2], o3 = last ? nvo[3] : cvo[3];
            if constexpr (F8) {
            PG_LDB8(B08, 0, 0); PG_LDB8(B18, 0, 1); PG_SCHED; PG_LDA8(At8, 0, 0); PG_STAGE_A(PG_SA(1, 1), a1, cvo[2], cvo[3]);
            PG_WAIT_V(8); PG_WAIT_L(0); PG_BAR; if constexpr (first) { PG_MMA8Z(0, 0, At8, B08); PG_MMA8Z(0, 1, At8, B18); } else { PG_MMA8(0, 0, At8, B08); PG_MMA8(0, 1, At8, B18); } PG_BAR; PG_SCHED;
            PG_LDA8(At8, 0, 1); PG_STAGE_B(PG_SB(0, 0), b2); PG_STAGE_B(PG_SB(0, 1), b2 + hstep); PG_STAGE_A(PG_SA(0, 0), a2, o0, o1);
            PG_WAIT_V(8); PG_WAIT_L(0); PG_BAR; if constexpr (first) { PG_MMA8Z(1, 0, At8, B08); PG_MMA8Z(1, 1, At8, B18); } else { PG_MMA8(1, 0, At8, B08); PG_MMA8(1, 1, At8, B18); } PG_BAR; PG_SCHED;
            PG_LDB8(B08, 1, 0); PG_LDB8(B18, 1, 1); PG_SCHED; PG_LDA8(At8, 1, 0); PG_STAGE_A(PG_SA(0, 1), a2, o2, o3);
            PG_WAIT_V(8); PG_WAIT_L(0); PG_BAR; PG_MMA8(0, 0, At8, B08); PG_MMA8(0, 1, At8, B18); PG_BAR; PG_SCHED;
            PG_LDA8(At8, 1, 1); PG_STAGE_B(PG_SB(1, 0), b3); PG_STAGE_B(PG_SB(1, 1), b3 + hstep); PG_STAGE_A(PG_SA(1, 0), a3, o0, o1);
            PG_WAIT_V(8); PG_WAIT_L(0); PG_BAR; PG_MMA8(1, 0, At8, B08); PG_MMA8(1, 1, At8, B18); PG_BAR; PG_SCHED;
            } else {
            PG_LDB(B0, 0, 0); PG_LDB(B1, 0, 1); PG_SCHED; PG_LDA(At, 0, 0); PG_STAGE_A(PG_SA(1, 1), a1, cvo[2], cvo[3]);
            PG_WAIT_V(8); PG_WAIT_L(0); PG_BAR; PG_MMA(0, 0, At, B0); PG_MMA(0, 1, At, B1); PG_BAR; PG_SCHED;
            PG_LDA(At, 0, 1); PG_STAGE_B(PG_SB(0, 0), b2); PG_STAGE_B(PG_SB(0, 1), b2 + hstep); PG_STAGE_A(PG_SA(0, 0), a2, o0, o1);
            PG_WAIT_V(8); PG_WAIT_L(0); PG_BAR; PG_MMA(1, 0, At, B0); PG_MMA(1, 1, At, B1); PG_BAR; PG_SCHED;
            PG_LDB(B0, 1, 0); PG_LDB(B1, 1, 1); PG_SCHED; PG_LDA(At, 1, 0); PG_STAGE_A(PG_SA(0, 1), a2, o2, o3);
            PG_WAIT_V(8); PG_WAIT_L(0); PG_BAR; PG_MMA(0, 0, At, B0); PG_MMA(0, 1, At, B1); PG_BAR; PG_SCHED;
            PG_LDA(At, 1, 1); PG_STAGE_B(PG_SB(1, 0), b3); PG_STAGE_B(PG_SB(1, 1), b3 + hstep); PG_STAGE_A(PG_SA(1, 0), a3, o0, o1);
            PG_WAIT_V(8); PG_WAIT_L(0); PG_BAR; PG_MMA(1, 0, At, B0); PG_MMA(1, 1, At, B1); PG_BAR; PG_SCHED;
        }
        };
        if constexpr (P::PEEL && PG_PEEL) {
            kpair(std::true_type{}, std::false_type{}, 0);
#pragma unroll 1
            for (int t = 2; t < nt - 2; t += 2) kpair(std::false_type{}, std::false_type{}, t);
            if (has_next) p.a_off_lds(nxt, Rr, Cc, nvo); else { nvo[0] = cvo[0]; nvo[1] = cvo[1]; nvo[2] = cvo[2]; nvo[3] = cvo[3]; }
            kpair(std::false_type{}, std::true_type{}, nt - 2);
        } else {
#pragma unroll 1
            for (int t = 0; t < nt; t += 2) kpair(std::false_type{}, t == nt - 2, t);
        }
        if (wr == 0) PG_BAR;
        if constexpr (F8) asm volatile("s_nop 15\n\ts_nop 15" ::: "memory");
        if constexpr (!(MODE & 1)) p.epi(acc, cur, wr, wc, fr, fq, ui & 1);
        else { _Pragma("unroll") for (int a = 0; a < 2; ++a) _Pragma("unroll") for (int b = 0; b < 2; ++b) _Pragma("unroll") for (int m = 0; m < 4; ++m) _Pragma("unroll") for (int n = 0; n < 2; ++n) asm volatile("" :: "v"(acc[a][b][m][n])); }
        if constexpr (P::PH == EPI_TWICE) { asm volatile("" ::: "memory");
#pragma unroll
            for (int a = 0; a < 2; ++a)
#pragma unroll
                for (int b = 0; b < 2; ++b)
#pragma unroll
                    for (int m = 0; m < 4; ++m)
#pragma unroll
                        for (int n = 0; n < 2; ++n) asm volatile("" : "+v"(acc[a][b][m][n]));
            p.epi(acc, cur, wr, wc, fr, fq, ui & 1); }
        if (!has_next) break;
        if constexpr (!(P::PEEL && PG_PEEL)) {
#pragma unroll
        for (int a = 0; a < 2; ++a)
#pragma unroll
            for (int b = 0; b < 2; ++b)
#pragma unroll
                for (int m = 0; m < 4; ++m)
#pragma unroll
                    for (int n = 0; n < 2; ++n) acc[a][b][m][n] = (f32x4){0.f, 0.f, 0.f, 0.f};
        }
        cur = nxt; cB = nB; cvo[0] = nvo[0]; cvo[1] = nvo[1]; cvo[2] = nvo[2]; cvo[3] = nvo[3]; ++ui;
        if constexpr (P::EPI_TABLE) p.epi_table(cur, ui & 1, wid, lane);
        if (wr == 1) PG_BAR;
    }
    PG_WAIT_V(0);
    PG_BAR;
#undef PG_SA
#undef PG_SB
#undef PG_STAGE_A
#undef PG_STAGE_B
#undef PG_LDA
#undef PG_LDB
#undef PG_MMA
#undef PG_MMA8
#undef PG_LDA8
#undef PG_LDB8
#undef PG_WAIT_V
#undef PG_WAIT_L
#undef PG_BAR
#undef PG_SCHED
}
}

struct Args {
    const float* in[23]; float* out; unsigned char* ws; int ph_lo, ph_hi;
};
struct Frame {
    LAS unsigned char* lds; unsigned* ctl; unsigned char* ws;
    int tid, lane, wave, G, bid;
};

template <bool TO_FP8>
__device__ __forceinline__ void p0_transpose_item(const float* W, int K, int N, bf16_t* WT, LAS float* scr, int item, int lane, const float* kscale = nullptr) {
    const int nblk = N / 32, kb = item / nblk, nb = item % nblk, k0 = 64 * kb, n0 = 32 * nb;
#pragma unroll 8
    for (int i = 0; i < 32; ++i) { const int kk = 2 * i + (lane >> 5); scr[kk * 33 + (lane & 31)] = W[(size_t)(k0 + kk) * N + n0 + (lane & 31)]; }
    LDS_WAIT(); asm volatile("" ::: "memory");
    const int c = lane & 7;
    f32x4 g0 = (f32x4){1.f, 1.f, 1.f, 1.f}, g1 = g0;
    if (kscale) { g0 = *(const f32x4*)(kscale + k0 + 8 * c); g1 = *(const f32x4*)(kscale + k0 + 8 * c + 4); }
    if (TO_FP8) { g0 = g0 * F8_WSCALE; g1 = g1 * F8_WSCALE; }
#pragma unroll
    for (int j = 0; j < 4; ++j) { const int n = (lane >> 3) + 8 * j; const LAS float* s = scr + (8 * c) * 33 + n;
        u32x4 o; o.x = cvt_pk_bf16(s[0 * 33] * g0.x, s[1 * 33] * g0.y); o.y = cvt_pk_bf16(s[2 * 33] * g0.z, s[3 * 33] * g0.w); o.z = cvt_pk_bf16(s[4 * 33] * g1.x, s[5 * 33] * g1.y); o.w = cvt_pk_bf16(s[6 * 33] * g1.z, s[7 * 33] * g1.w);
        if (TO_FP8) { u32x2 q; q.x = cvt4_fp8(s[0 * 33] * g0.x, s[1 * 33] * g0.y, s[2 * 33] * g0.z, s[3 * 33] * g0.w); q.y = cvt4_fp8(s[4 * 33] * g1.x, s[5 * 33] * g1.y, s[6 * 33] * g1.z, s[7 * 33] * g1.w);
            *(u32x2*)((unsigned char*)WT + (size_t)(n0 + n) * K + k0 + 8 * c) = q; }
        else *(u32x4*)(WT + (size_t)(n0 + n) * K + k0 + 8 * c) = o; }
    LDS_WAIT(); asm volatile("" ::: "memory");
}

__device__ __forceinline__ int rel_bucket_dev(int rel) {
    const int side = rel > 0 ? 16 : 0; const int n = rel < 0 ? -rel : rel;
    const float nf = (float)(n > 1 ? n : 1);
    int large = 8 + (int)(logf(nf / 8.0f) / 2.772588722239781f * 8.0f);
    large = large < 15 ? large : 15;
    return side + (n < 8 ? n : large);
}

__device__ __forceinline__ void phase0(const Frame& F, const Args& A) {
    LAS float* scr = (LAS float*)(F.lds + F.wave * 16384);
    const int gw = F.bid * NWAVES + F.wave, NGW = F.G * NWAVES;
    const int gt = F.bid * NTHR + F.tid, NGT = F.G * NTHR;
    bf16_t* WinT = (bf16_t*)(F.ws + WS_WIN); bf16_t* WoT = (bf16_t*)(F.ws + WS_WOUT); bf16_t* W1T = (bf16_t*)(F.ws + WS_W1); bf16_t* W2T = (bf16_t*)(F.ws + WS_W2);
    constexpr int I_IN = 16 * 80, I_OUT = 16 * 32, I_1 = 16 * 64, I_2 = 16 * 32;
    constexpr int NITEMS = I_IN + I_OUT + NEXP * I_1 + NEXP * I_2;
    for (int it = gw; it < NITEMS; it += NGW) {
        int r = it;
        if (r < I_IN) { p0_transpose_item<false>(A.in[3], 1024, DIN, WinT, scr, r, F.lane); continue; } r -= I_IN;
        if (r < I_OUT) { p0_transpose_item<false>(A.in[14], 1024, 1024, WoT, scr, r, F.lane); continue; } r -= I_OUT;
        if (r < NEXP * I_1) { const int e = r / I_1; p0_transpose_item<true>(A.in[18] + (size_t)e * 1024 * 2048, 1024, 2048, (bf16_t*)((unsigned char*)W1T + (size_t)e * 2048 * 1024), scr, r % I_1, F.lane, A.in[15]); continue; } r -= NEXP * I_1;
        { const int e = r / I_2; p0_transpose_item<true>(A.in[20] + (size_t)e * 1024 * 1024, 1024, 1024, (bf16_t*)((unsigned char*)W2T + (size_t)e * 1024 * 1024), scr, r % I_2, F.lane); }
    }
    { bf16_t* SW = (bf16_t*)(F.ws + WS_SGUW); const float* w = A.in[6];
      for (int i = gt; i < 4 * 128 * 128 / 2; i += NGT) { const int e0 = 2 * i, ii = (e0 >> 7) & 127, jj = e0 & 127; const bool vis = (jj >> 6) <= (ii >> 6);
          const float a = vis ? w[e0] : 0.f, b = vis ? w[e0 + 1] : 0.f; ((unsigned*)SW)[i] = cvt_pk_bf16(a, b); } }
    { float* tbl = (float*)(F.ws + WS_TBL); const float* rt = A.in[1];
      for (int i = gt; i < 4 * 256; i += NGT) { const int h = i >> 8, idx = i & 255; const int rel = idx - 191; float v = 0.f;
          if (idx < 255) v = (rt[rel_bucket_dev(rel) * 4 + h] - rt[15 * 4 + h]) * LOG2E; tbl[i] = v; } }
    { bf16_t* WH = (bf16_t*)(F.ws + WS_WRH); bf16_t* WL = (bf16_t*)(F.ws + WS_WRL); const float* rw = A.in[16]; const float* g = A.in[15];
      for (int i = gt; i < 32 * 1024; i += NGT) { const int k = i >> 5, e = i & 31; const float v = rw[i] * g[k];
          const unsigned hi = cvt_pk_bf16(v, 0.f) & 0xffffu; const float r = v - bf_lo(hi); const unsigned lo = cvt_pk_bf16(r, 0.f) & 0xffffu;
          WH[e * 1024 + k] = (bf16_t)hi; WL[e * 1024 + k] = (bf16_t)lo; } }
    { bf16_t* H = (bf16_t*)(F.ws + WS_H); const float* x = A.in[0]; const f32x4* gq = (const f32x4*)A.in[2] + F.lane;
      f32x4 gv[4];
#pragma unroll
      for (int j = 0; j < 4; ++j) gv[j] = gq[64 * j];
      for (int m = gw; m < NTOK; m += NGW) {
          const f32x4* xr = (const f32x4*)(x + (size_t)m * DM) + F.lane; f32x4 v[4]; float s = 0.f;
#pragma unroll
          for (int j = 0; j < 4; ++j) { v[j] = xr[64 * j]; s += (v[j].x * v[j].x + v[j].y * v[j].y) + (v[j].z * v[j].z + v[j].w * v[j].w); }
          const float rstd = __builtin_amdgcn_rsqf(wave_sum(s) * (1.f / DM) + NORM_EPS);
          u32x2* o8 = (u32x2*)(H + (size_t)m * DM) + F.lane;
#pragma unroll
          for (int j = 0; j < 4; ++j) { u32x2 w; w.x = cvt_pk_bf16(v[j].x * rstd * gv[j].x, v[j].y * rstd * gv[j].y); w.y = cvt_pk_bf16(v[j].z * rstd * gv[j].z, v[j].w * rstd * gv[j].w); o8[64 * j] = w; }
      } }
}

struct InProj {
    struct Unit { int pm, pn; };
    static constexpr bool PERM = true, FP8 = false, EPI_TABLE = false; static constexpr int PH = 1; static constexpr bool PEEL = false;
    const bf16_t* A; const bf16_t* Bt; bf16_t* O; float* KP; int G, c;
    __device__ __forceinline__ bool next(int i, Unit& u) const { return pg::tile_order(i, G, c, NTOK / 256, DIN / 256, u.pm, u.pn); }
    __device__ __forceinline__ void a_off(const Unit& u, const int (&R)[2], const int (&C)[2], unsigned (&o)[4]) const {
#pragma unroll
        for (int h = 0; h < 2; ++h)
#pragma unroll
            for (int i = 0; i < 2; ++i) o[h * 2 + i] = (unsigned)((u.pm * 256 + h * 128 + R[i]) * 1024 + C[i]) * 2u;
    }
    __device__ __forceinline__ const char* a_base() const { return (const char*)A; }
    __device__ __forceinline__ const char* b_ptr(const Unit& u) const { return (const char*)(Bt + (size_t)u.pn * 256 * 1024); }
    __device__ __forceinline__ void epi(const f32x4 (&acc)[2][2][4][2], const Unit& u, int wr, int wc, int fr, int fq, int) const {
        const int buf = u.pn >> 1; bf16_t* base = O + (size_t)buf * PBUF_STRIDE;
        const int row0 = u.pm * 256 + wr * 64 + fr, col0 = (u.pn & 1) * 256 + wc * 32 + 8 * fq;
        const bool act = u.pn < 4; const float sc = (buf == 2) ? QSCALE : 1.0f;
#pragma unroll
        for (int ai = 0; ai < 2; ++ai)
#pragma unroll
            for (int m = 0; m < 4; ++m) { const int r = row0 + ai * 128 + m * 16;
#pragma unroll
                for (int bj = 0; bj < 2; ++bj) { f32x4 v0 = acc[ai][bj][m][0], v1 = acc[ai][bj][m][1];
                    if (act) { f32x2 a = gelu_pk((f32x2){v0[0], v0[1]}), b = gelu_pk((f32x2){v0[2], v0[3]}), c2 = gelu_pk((f32x2){v1[0], v1[1]}), d = gelu_pk((f32x2){v1[2], v1[3]});
                        v0 = (f32x4){a.x, a.y, b.x, b.y}; v1 = (f32x4){c2.x, c2.y, d.x, d.y}; }
                    v0 = v0 * sc; v1 = v1 * sc; u32x4 w; w.x = cvt_pk_bf16(v0[0], v0[1]); w.y = cvt_pk_bf16(v0[2], v0[3]); w.z = cvt_pk_bf16(v1[0], v1[1]); w.w = cvt_pk_bf16(v1[2], v1[3]);
                    const int col = col0 + bj * 128;
                    size_t eoff;
                    if (buf < 3) eoff = (size_t)r * 512 + col;
                    else { const int bb = r >> 13, pos = r & 8191, tile = pos >> 6, row = pos & 63, hh = col >> 7;
                        const size_t img = ((size_t)((bb * 4 + hh) * 128 + tile)) * 8192;
                        if (buf == 3) { const int sub = (col >> 5) & 3, gl = (col >> 3) & 3; eoff = img + sub * 2048 + row * 32 + ((gl ^ ((0x78 >> (2 * ((row >> 3) & 3))) & 3)) * 8); }
                        else { const int c = (col >> 4) & 7, hf = (col >> 3) & 1, prow = (row & 0x33) | (((row >> 3) & 1) << 2) | (((row >> 2) & 1) << 3); eoff = img + c * 1024 + prow * 16 + hf * 8; } }
                    *(u32x4*)(base + eoff) = w; } }
        if (buf == 3) {
#pragma unroll
            for (int ai = 0; ai < 2; ++ai)
#pragma unroll
                for (int bj = 0; bj < 2; ++bj) { float mx = 0.f;
#pragma unroll
                    for (int m = 0; m < 4; ++m) { const f32x4 v0 = acc[ai][bj][m][0], v1 = acc[ai][bj][m][1];
                        float ss = (v0[0] * v0[0] + v0[1] * v0[1]) + (v0[2] * v0[2] + v0[3] * v0[3]) + (v1[0] * v1[0] + v1[1] * v1[1]) + (v1[2] * v1[2] + v1[3] * v1[3]);
                        ss += __shfl_xor(ss, 16); ss += __shfl_xor(ss, 32); mx = fmaxf(mx, ss); }
#pragma unroll
                    for (int o = 1; o < 16; o <<= 1) mx = fmaxf(mx, __shfl_xor(mx, o));
                    if (fr == 0 && fq == 0) { const int r = u.pm * 256 + wr * 64 + ai * 128, bb = r >> 13, tile = (r & 8191) >> 6, hh = 2 * (u.pn & 1) + bj;
                        KP[((((bb * 4 + hh) * 128 + tile) * 2 + (wc >> 1)) * 2) + (wc & 1)] = mx; } }
        }
    }
};

struct OutProj {
    struct Unit { int pm, pn; };
    static constexpr bool PERM = true, FP8 = false, EPI_TABLE = false; static constexpr int PH = 4; static constexpr bool PEEL = false;
    const bf16_t* A; const bf16_t* Bt; bf16_t* O; int G, c;
    __device__ __forceinline__ bool next(int i, Unit& u) const {
        if (G == NTOK / 256) { if (i >= DM / 256) return false; u.pm = c; u.pn = i; return true; }
        return pg::tile_order(i, G, c, NTOK / 256, DM / 256, u.pm, u.pn); }
    __device__ __forceinline__ void a_off(const Unit& u, const int (&R)[2], const int (&C)[2], unsigned (&o)[4]) const {
#pragma unroll
        for (int h = 0; h < 2; ++h)
#pragma unroll
            for (int i = 0; i < 2; ++i) o[h * 2 + i] = (unsigned)((u.pm * 256 + h * 128 + R[i]) * 1024 + C[i]) * 2u;
    }
    __device__ __forceinline__ const char* a_base() const { return (const char*)A; }
    __device__ __forceinline__ const char* b_ptr(const Unit& u) const { return (const char*)(Bt + (size_t)u.pn * 256 * 1024); }
    __device__ __forceinline__ void epi(const f32x4 (&acc)[2][2][4][2], const Unit& u, int wr, int wc, int fr, int fq, int) const {
        const int row0 = u.pm * 256 + wr * 64 + fr, col0 = u.pn * 256 + wc * 32 + 8 * fq;
#pragma unroll
        for (int ai = 0; ai < 2; ++ai)
#pragma unroll
            for (int m = 0; m < 4; ++m) { bf16_t* rowp = O + (size_t)(row0 + ai * 128 + m * 16) * 2048 + col0;
#pragma unroll
                for (int bj = 0; bj < 2; ++bj) { const f32x4 v0 = acc[ai][bj][m][0], v1 = acc[ai][bj][m][1];
                    u32x4 w; w.x = cvt_pk_bf16(v0[0], v0[1]); w.y = cvt_pk_bf16(v0[2], v0[3]); w.z = cvt_pk_bf16(v1[0], v1[1]); w.w = cvt_pk_bf16(v1[2], v1[3]);
                    *(u32x4*)(rowp + bj * 128) = w; } }
    }
};

#ifndef MOE_WGM
#define MOE_WGM 8
#endif
struct MoeUnit { int e, row0, cnt, pn, lrow; };
__device__ __forceinline__ bool moe_next(int i, int G, int c, int nN, const LAS int* tp, const LAS int* rs, MoeUnit& u) {
    const int nM = __builtin_amdgcn_readfirstlane(tp[32]); int pm, pn;
    if (!pg::tile_order<MOE_WGM>(i, G, c, nM, nN, pm, pn)) return false;
    const int j = (int)(threadIdx.x & 31u); const int tj = tp[j], rj = rs[j], rj1 = rs[j + 1];
    const int e = __popcll(__ballot((threadIdx.x & 63u) >= 1u && (threadIdx.x & 63u) < 32u && tj <= pm));
    const int tpe = __builtin_amdgcn_readlane(tj, e), rse = __builtin_amdgcn_readlane(rj, e), rse1 = __builtin_amdgcn_readlane(rj1, e);
    u.e = e; u.row0 = rse + (pm - tpe) * 256; const int rem = rse1 - u.row0; u.cnt = rem < 256 ? rem : 256; u.pn = pn; u.lrow = e * LCAP + (pm - tpe) * 256;
    return true;
}
struct Moe1 {
    typedef MoeUnit Unit;
    static constexpr int PERM = 2; static constexpr bool FP8 = true, EPI_TABLE = true; static constexpr int PH = 7; static constexpr bool PEEL = true;
    const bf16_t* H2; const bf16_t* W1T; const float* b1; bf16_t* ACT; const int* list; const float* rss; const LAS int* tp; const LAS int* rs; int G, c;
    __device__ __forceinline__ bool next(int i, Unit& u) const { return moe_next(i, G, c, 8, tp, rs, u); }
    __device__ __forceinline__ void a_off(const Unit& u, const int (&R)[2], const int (&C)[2], unsigned (&o)[4]) const {
#pragma unroll
        for (int h = 0; h < 2; ++h)
#pragma unroll
            for (int i = 0; i < 2; ++i) { int r = h * 128 + R[i]; r = r < u.cnt ? r : u.cnt - 1; const int slot = list[u.lrow + r]; o[h * 2 + i] = (unsigned)((slot >> 2) * 1024 + C[i] * 2); }
    }
    __device__ __forceinline__ void list_dma(const Unit& u, int wid, int lane) const {
        if (wid < 4) pg::glds4s(list + u.lrow + 64 * wid, (unsigned)lane * 4u, (unsigned)__builtin_amdgcn_readfirstlane((unsigned)(size_t)tp + 1024 + wid * 256));
    }
    __device__ __forceinline__ void a_off_lds(const Unit& u, const int (&R)[2], const int (&C)[2], unsigned (&o)[4]) const {
        const LAS int* lst = (const LAS int*)((const LAS unsigned char*)tp + 1024);
#pragma unroll
        for (int h = 0; h < 2; ++h)
#pragma unroll
            for (int i = 0; i < 2; ++i) { int r = h * 128 + R[i]; r = r < u.cnt ? r : u.cnt - 1; const int slot = lst[r]; o[h * 2 + i] = (unsigned)((slot >> 2) * 1024 + C[i] * 2); }
    }
    __device__ __forceinline__ void epi_table(const Unit& u, int par, int wid, int lane) const {
        const float* src = wid < 4 ? rss + u.lrow + 64 * wid : b1 + (size_t)u.e * 2048 + u.pn * 256 + 64 * (wid - 4);
        pg::glds4s(src, (unsigned)lane * 4u, (unsigned)__builtin_amdgcn_readfirstlane((unsigned)(size_t)tp - L_MISC + L_TBL + par * 2048 + wid * 256));
    }
    __device__ __forceinline__ const char* a_base() const { return (const char*)H2; }
    __device__ __forceinline__ const char* b_ptr(const Unit& u) const { return (const char*)W1T + ((size_t)u.e * 2048 + (size_t)u.pn * 256) * 1024; }
    __device__ __forceinline__ void epi(const f32x4 (&acc)[2][2][4][2], const Unit& u, int wr, int wc, int fr, int fq, int par) const {
        const int r0 = wr * 64 + fr;
        const LAS float* tb = (const LAS float*)((const LAS unsigned char*)tp - L_MISC + L_TBL + par * 2048);
        f32x4 bv[2][2];
#pragma unroll
        for (int bj = 0; bj < 2; ++bj)
#pragma unroll
            for (int n = 0; n < 2; ++n) { const f32x4 b = *(const LAS f32x4*)(tb + 256 + wc * 32 + 8 * fq + bj * 128 + 4 * n); bv[bj][n] = (f32x4){b.x, b.z, b.y, b.w}; }
#pragma unroll
        for (int ai = 0; ai < 2; ++ai) {
            float rsv[4];
#pragma unroll
            for (int m = 0; m < 4; ++m) rsv[m] = tb[r0 + ai * 128 + m * 16] * (1.0f / (F8_XSCALE * F8_WSCALE));
            const int rs_ = r0 + ai * 128 + fq * 16;
            unsigned char* rowp = (unsigned char*)ACT + (size_t)(u.row0 + rs_) * 1024 + u.pn * 128 + wc * 16;
#pragma unroll
            for (int bj = 0; bj < 2; ++bj) { unsigned w[4];
#pragma unroll
                for (int m = 0; m < 4; ++m) { f32x2 a[2];
#pragma unroll
                    for (int n = 0; n < 2; ++n) { const f32x4 v = acc[ai][bj][m][n] * rsv[m] + bv[bj][n];
                        f32x2 g = (f32x2){fminf(v.x, 7.0f), fminf(v.y, 7.0f)}; const f32x2 l = (f32x2){fminf(fmaxf(v.z, -7.0f), 7.0f), fminf(fmaxf(v.w, -7.0f), 7.0f)};
                        const f32x2 z = g * (-1.702f * LOG2E); f32x2 d = (f32x2){__builtin_amdgcn_exp2f(z.x), __builtin_amdgcn_exp2f(z.y)}; d = d + 1.0f;
                        const f32x2 sg = (f32x2){__builtin_amdgcn_rcpf(d.x), __builtin_amdgcn_rcpf(d.y)};
                        a[n] = (g * sg) * (l * F8_ASCALE + F8_ASCALE); }
                    w[m] = cvt4_fp8(a[0].x, a[0].y, a[1].x, a[1].y); }
                { auto p = __builtin_amdgcn_permlane16_swap(w[0], w[1], false, false); w[0] = p[0]; w[1] = p[1]; }
                { auto p = __builtin_amdgcn_permlane16_swap(w[2], w[3], false, false); w[2] = p[0]; w[3] = p[1]; }
                { auto p = __builtin_amdgcn_permlane32_swap(w[0], w[2], false, false); w[0] = p[0]; w[2] = p[1]; }
                { auto p = __builtin_amdgcn_permlane32_swap(w[1], w[3], false, false); w[1] = p[0]; w[3] = p[1]; }
                if (rs_ < u.cnt) *(u32x4*)(rowp + bj * 64) = (u32x4){w[0], w[1], w[2], w[3]}; } }
    }
};
struct Moe2 {
    typedef MoeUnit Unit;
    static constexpr bool PERM = true, FP8 = true, EPI_TABLE = true; static constexpr int PH = 8; static constexpr bool PEEL = true;
    const bf16_t* ACT; const bf16_t* W2T; const float* b2; bf16_t* Y; const int* list; int slot_base; const LAS int* tp; const LAS int* rs; int G, c;
    __device__ __forceinline__ bool next(int i, Unit& u) const { return moe_next(i, G, c, 4, tp, rs, u); }
    __device__ __forceinline__ void a_off(const Unit& u, const int (&R)[2], const int (&C)[2], unsigned (&o)[4]) const {
#pragma unroll
        for (int h = 0; h < 2; ++h)
#pragma unroll
            for (int i = 0; i < 2; ++i) o[h * 2 + i] = (unsigned)((u.row0 + h * 128 + R[i]) * 1024 + C[i] * 2);
    }
    __device__ __forceinline__ void list_dma(const Unit&, int, int) const {}
    __device__ __forceinline__ void a_off_lds(const Unit& u, const int (&R)[2], const int (&C)[2], unsigned (&o)[4]) const { a_off(u, R, C, o); }
    __device__ __forceinline__ void epi_table(const Unit& u, int par, int wid, int lane) const {
        const void* src = wid < 4 ? (const void*)(list + u.lrow + 64 * wid) : (const void*)(b2 + (size_t)u.e * 1024 + u.pn * 256 + 64 * (wid - 4));
        pg::glds4s(src, (unsigned)lane * 4u, (unsigned)__builtin_amdgcn_readfirstlane((unsigned)(size_t)tp - L_MISC + L_TBL + par * 2048 + wid * 256));
    }
    __device__ __forceinline__ const char* a_base() const { return (const char*)ACT; }
    __device__ __forceinline__ const char* b_ptr(const Unit& u) const { return (const char*)W2T + ((size_t)u.e * 1024 + (size_t)u.pn * 256) * 1024; }
    __device__ __forceinline__ void epi(const f32x4 (&acc)[2][2][4][2], const Unit& u, int wr, int wc, int fr, int fq, int par) const {
        const int r0 = wr * 64 + fr, col0 = u.pn * 256 + wc * 32 + 16 * (fq >> 1);
        const LAS float* tb = (const LAS float*)((const LAS unsigned char*)tp - L_MISC + L_TBL + par * 2048);
        f32x4 bv[2][2];
#pragma unroll
        for (int bj = 0; bj < 2; ++bj) { bv[bj][0] = *(const LAS f32x4*)(tb + 256 + wc * 32 + 8 * fq + bj * 128) * F8_YSCALE; bv[bj][1] = *(const LAS f32x4*)(tb + 256 + wc * 32 + 8 * fq + bj * 128 + 4) * F8_YSCALE; }
        int slots[2][2];
#pragma unroll
        for (int ai = 0; ai < 2; ++ai)
#pragma unroll
            for (int mp = 0; mp < 2; ++mp) slots[ai][mp] = ((const LAS int*)tb)[r0 + ai * 128 + (2 * mp + (fq & 1)) * 16];
#pragma unroll
        for (int ai = 0; ai < 2; ++ai)
#pragma unroll
            for (int mp = 0; mp < 2; ++mp) { const int r = r0 + ai * 128 + (2 * mp + (fq & 1)) * 16; const bool ok = r < u.cnt;
                const int slot = ok ? (slots[ai][mp] - slot_base) : 0;
                unsigned char* rowp = (unsigned char*)Y + (size_t)slot * 1024 + col0;
#pragma unroll
                for (int bj = 0; bj < 2; ++bj) { u32x2 w[2];
#pragma unroll
                    for (int q = 0; q < 2; ++q) { const int m = 2 * mp + q;
                        const f32x4 v0 = acc[ai][bj][m][0] * (F8_YSCALE / (F8_ASCALE * F8_WSCALE)) + bv[bj][0], v1 = acc[ai][bj][m][1] * (F8_YSCALE / (F8_ASCALE * F8_WSCALE)) + bv[bj][1];
                        w[q].x = cvt4_fp8(v0[0], v0[1], v0[2], v0[3]); w[q].y = cvt4_fp8(v1[0], v1[1], v1[2], v1[3]); }
                    { auto p = __builtin_amdgcn_permlane16_swap(w[0].x, w[1].x, false, false); w[0].x = p[0]; w[1].x = p[1]; }
                    { auto p = __builtin_amdgcn_permlane16_swap(w[0].y, w[1].y, false, false); w[0].y = p[0]; w[1].y = p[1]; }
                    if (ok) *(u32x4*)(rowp + bj * 128) = (u32x4){w[0].x, w[0].y, w[1].x, w[1].y}; } }
    }
};

__device__ __forceinline__ void moe_tables(const Frame& F) {
    LAS int* tp = (LAS int*)(F.lds + L_MISC); LAS int* rs = tp + 64;
    __syncthreads();
    if (F.tid < 64) {
        const int c = F.tid < 32 ? (int)__hip_atomic_load(F.ctl + CW_CUR + F.tid, __ATOMIC_RELAXED, __HIP_MEMORY_SCOPE_AGENT) : 0;
        int t = (c + 255) >> 8, r = c;
#pragma unroll
        for (int o = 1; o < 32; o <<= 1) { const int tu = __shfl_up(t, o), ru = __shfl_up(r, o); if (F.lane >= o) { t += tu; r += ru; } }
        if (F.tid < 32) { tp[F.tid + 1] = t; rs[F.tid + 1] = r; if (F.tid == 0) { tp[0] = 0; rs[0] = 0; } } }
    __syncthreads();
}

__device__ __forceinline__ unsigned off_b(unsigned row, unsigned ch) { return 256u * row + 16u * (ch ^ (((row & 3u) << 2) | ((row >> 2) & 3u))); }
__device__ __forceinline__ s16x4 tr_read(LAS const unsigned char* p) { return __builtin_bit_cast(s16x4, __builtin_amdgcn_ds_read_tr16_b64_v4i16((LAS s16x4*)p)); }
#define RAW_BAR() do { asm volatile("" ::: "memory"); __builtin_amdgcn_s_barrier(); asm volatile("" ::: "memory"); } while (0)

__device__ __forceinline__ void sgu_unit(const Frame& F, const Args& A, int unit) {
    int lane = F.lane; asm volatile("" : "+v"(lane));
    const int wid = F.wave;
    const bf16_t* wrow = (const bf16_t*)(F.ws + WS_SGUW) + (wid >> 1) * 16384 + ((wid & 1) * 64 + (lane & 31)) * 128 + 8 * (lane >> 5);
    const size_t tok0 = (size_t)unit * 128;
    const bf16_t* U = (const bf16_t*)(F.ws + WS_U); const bf16_t* VG = U + PBUF_STRIDE; bf16_t* MIX = (bf16_t*)(F.ws + WS_MIX);
    {
        const f32x4* lg = (const f32x4*)A.in[4] + 2 * lane; const f32x4* lb = (const f32x4*)A.in[5] + 2 * lane;
        const f32x4 g0 = lg[0], g1 = lg[1], b0 = lb[0], b1 = lb[1];
        u32x4 raw[16];
#pragma unroll
        for (int i = 0; i < 16; ++i) raw[i] = *((const u32x4*)(VG + (tok0 + wid * 16 + i) * 512) + lane);
#pragma unroll
        for (int i = 0; i < 16; ++i) {
            float v[8]; v[0] = bf_lo(raw[i].x); v[1] = bf_hi(raw[i].x); v[2] = bf_lo(raw[i].y); v[3] = bf_hi(raw[i].y); v[4] = bf_lo(raw[i].z); v[5] = bf_hi(raw[i].z); v[6] = bf_lo(raw[i].w); v[7] = bf_hi(raw[i].w);
            float s = 0.f;
#pragma unroll
            for (int j = 0; j < 8; ++j) s += v[j];
            const float mean = wave_sum(s) * (1.f / 512.f); float q = 0.f;
#pragma unroll
            for (int j = 0; j < 8; ++j) { v[j] -= mean; q += v[j] * v[j]; }
            const float rstd = __builtin_amdgcn_rsqf(wave_sum(q) * (1.f / 512.f) + NORM_EPS);
            u32x4 w;
            w.x = cvt_pk_bf16(v[0] * rstd * g0.x + b0.x, v[1] * rstd * g0.y + b0.y); w.y = cvt_pk_bf16(v[2] * rstd * g0.z + b0.z, v[3] * rstd * g0.w + b0.w);
            w.z = cvt_pk_bf16(v[4] * rstd * g1.x + b1.x, v[5] * rstd * g1.y + b1.y); w.w = cvt_pk_bf16(v[6] * rstd * g1.z + b1.z, v[7] * rstd * g1.w + b1.w);
            const unsigned row = wid * 16 + i;
            *(LAS u32x4*)(F.lds + (lane >> 4) * 32768 + ((lane & 15) >> 2) * 8192 + row * 64 + (lane & 3) * 16) = w;
        }
    }
    __syncthreads();
    const int gi = wid >> 1, ih = wid & 1, il = lane & 31, hh = lane >> 5;
    bf16x8 wf[4][2];
#pragma unroll
    for (int ks = 0; ks < 4; ++ks)
#pragma unroll
        for (int ib = 0; ib < 2; ++ib) wf[ks][ib] = *(const bf16x8*)(wrow + ib * 32 * 128 + 16 * ks);
    float bsv2[2];
#pragma unroll
    for (int ib = 0; ib < 2; ++ib) bsv2[ib] = A.in[7][gi * 128 + ih * 64 + ib * 32 + il];
    __builtin_amdgcn_sched_barrier(0);
    u32x4 uraw[16];
#pragma unroll
    for (int r = 0; r < 16; ++r) uraw[r] = *((const u32x4*)(U + (tok0 + wid * 16 + r) * 512) + lane);
    f32x16 acc[4][2];
#pragma unroll
    for (int cb = 0; cb < 4; ++cb)
#pragma unroll
        for (int ib = 0; ib < 2; ++ib)
#pragma unroll
            for (int r = 0; r < 16; ++r) acc[cb][ib][r] = 0.f;
    {
        const unsigned blk = (lane >> 4) & 1, q4 = (lane & 15) >> 2, p4 = lane & 3;
        unsigned ia = (unsigned)(size_t)F.lds + gi * 32768 + 64 * (8 * hh + q4) + 32 * blk + 8 * p4; asm volatile("" : "+v"(ia));
        LAS const unsigned char* img = (LAS const unsigned char*)(size_t)ia;
#pragma unroll
        for (int half = 0; half < 2; ++half) {
            if (half == 0 || ih == 1) {
                if (half == 1) {
#pragma unroll
                    for (int ks = 0; ks < 4; ++ks)
#pragma unroll
                        for (int ib = 0; ib < 2; ++ib) wf[ks][ib] = *(const bf16x8*)(wrow + ib * 32 * 128 + 16 * (4 + ks));
                    __builtin_amdgcn_sched_barrier(0);
                }
#pragma unroll
                for (int k4 = 0; k4 < 4; ++k4) { const int ks = 4 * half + k4;
#pragma unroll
                    for (int cb = 0; cb < 4; ++cb) {
                        const s16x4 lo = tr_read(img + 8192 * cb + 1024 * ks);
                        const s16x4 hi = tr_read(img + 8192 * cb + 1024 * ks + 256);
                        const bf16x8 af = (bf16x8){lo[0], lo[1], lo[2], lo[3], hi[0], hi[1], hi[2], hi[3]};
#pragma unroll
                        for (int ib = 0; ib < 2; ++ib) acc[cb][ib] = __builtin_amdgcn_mfma_f32_32x32x16_bf16(af, wf[k4][ib], acc[cb][ib], 0, 0, 0);
                    }
                }
            }
        }
    }
    constexpr int UP = 1040;
    __syncthreads();
#pragma unroll
    for (int r = 0; r < 16; ++r) *(LAS u32x4*)(F.lds + (wid * 16 + r) * UP + lane * 16) = uraw[r];
    __syncthreads();
    LAS float* stats = (LAS float*)(F.lds + L_MISC);
#pragma unroll
    for (int ib = 0; ib < 2; ++ib) {
        const int i = ih * 64 + ib * 32 + il; const float bsv = bsv2[ib]; float ss = 0.f;
        LAS const unsigned char* up = F.lds + i * UP + (gi * 128 + 4 * hh) * 2;
#pragma unroll
        for (int cb = 0; cb < 4; ++cb)
#pragma unroll
            for (int rr = 0; rr < 4; ++rr) { const u32x2 uw = *(LAS const u32x2*)(up + (cb * 32 + rr * 8) * 2);
                const float u0 = bf_lo(uw.x), u1 = bf_hi(uw.x), u2 = bf_lo(uw.y), u3 = bf_hi(uw.y);
                float a0 = (acc[cb][ib][rr * 4 + 0] + bsv) * u0, a1 = (acc[cb][ib][rr * 4 + 1] + bsv) * u1, a2 = (acc[cb][ib][rr * 4 + 2] + bsv) * u2, a3 = (acc[cb][ib][rr * 4 + 3] + bsv) * u3;
                acc[cb][ib][rr * 4 + 0] = a0; acc[cb][ib][rr * 4 + 1] = a1; acc[cb][ib][rr * 4 + 2] = a2; acc[cb][ib][rr * 4 + 3] = a3;
                ss += (a0 * a0 + a1 * a1) + (a2 * a2 + a3 * a3); }
        ss += __shfl_xor(ss, 32);
        if (hh == 0) stats[i * 4 + gi] = ss;
    }
    const float* og = A.in[8] + gi * 128 + 4 * hh;
    f32x4 ogv[16];
#pragma unroll
    for (int q = 0; q < 16; ++q) ogv[q] = *(const f32x4*)(og + (q >> 2) * 32 + (q & 3) * 8);
    __syncthreads();
#pragma unroll
    for (int ib = 0; ib < 2; ++ib) {
        const int i = ih * 64 + ib * 32 + il; const f32x4 st = *(LAS const f32x4*)(stats + i * 4);
        const float rstd = __builtin_amdgcn_rsqf(((st.x + st.y) + (st.z + st.w)) * (1.f / 512.f) + NORM_EPS);
        LAS unsigned char* op = F.lds + i * UP + (gi * 128 + 4 * hh) * 2;
#pragma unroll
        for (int cb = 0; cb < 4; ++cb)
#pragma unroll
            for (int rr = 0; rr < 4; ++rr) { const f32x4 gg = ogv[cb * 4 + rr];
                u32x2 w; w.x = cvt_pk_bf16(acc[cb][ib][rr * 4 + 0] * rstd * gg.x, acc[cb][ib][rr * 4 + 1] * rstd * gg.y); w.y = cvt_pk_bf16(acc[cb][ib][rr * 4 + 2] * rstd * gg.z, acc[cb][ib][rr * 4 + 3] * rstd * gg.w);
                *(LAS u32x2*)(op + (cb * 32 + rr * 8) * 2) = w; }
    }
    __syncthreads();
#pragma unroll
    for (int r = 0; r < 16; ++r) { const int row = wid * 16 + r; *((u32x4*)(MIX + (tok0 + row) * 1024) + lane) = *(LAS const u32x4*)(F.lds + row * UP + lane * 16); }
    __syncthreads();
}

constexpr int AT_SLOT = 16384, AT_K = 0, AT_V = 4 * AT_SLOT;
constexpr float AT_THR = 40.0f;
__device__ __forceinline__ float max3f(float a, float b, float c) { return fmaxf(fmaxf(a, b), c); }
__device__ __forceinline__ void glds16p(const void* sbase, unsigned voff, unsigned lds_dst) { unsigned keep;
    asm volatile("s_mov_b32 %0, m0\n\ts_mov_b32 m0, %3\n\ts_nop 3\n\tglobal_load_lds_dwordx4 %1, %2\n\tglobal_load_lds_dwordx4 %1, %2 offset:1024\n\ts_mov_b32 m0, %0"
                 : "=&s"(keep) : "v"(voff), "s"(sbase), "s"(lds_dst) : "memory"); }
__device__ __forceinline__ void glds16s(const void* sbase, unsigned voff, unsigned lds_dst) { unsigned keep;
    asm volatile("s_mov_b32 %0, m0\n\ts_mov_b32 m0, %3\n\ts_nop 3\n\tglobal_load_lds_dwordx4 %1, %2\n\ts_mov_b32 m0, %0" : "=&s"(keep) : "v"(voff), "s"(sbase), "s"(lds_dst) : "memory"); }
__device__ __forceinline__ void at_stage_y(f32x4 (&s)[2][4], const LAS float* tbl, bool near, int bbase, bool first, float bnd0, float bnd1, f32x4 (&o)[2][9], f32x4 (&negm)[2], bf16x8 (&pf)[2][2]) {
    if (near) {
#pragma unroll
        for (int blk = 0; blk < 4; ++blk)
#pragma unroll
            for (int r = 0; r < 4; ++r) { const float bv = tbl[bbase + 32 * (blk >> 1) + 4 * (blk & 1) + r]; s[0][blk][r] += bv; s[1][blk][r] += bv; }
    }
    if (first || __any(fmaxf(bnd0 + negm[0][0], bnd1 + negm[1][0]) > AT_THR)) {
        float mx[2];
#pragma unroll
        for (int m = 0; m < 2; ++m) {
            float a = max3f(s[m][0][0], s[m][0][1], s[m][0][2]), b = max3f(s[m][0][3], s[m][1][0], s[m][1][1]);
            a = max3f(a, s[m][1][2], s[m][1][3]); b = max3f(b, s[m][2][0], s[m][2][1]); a = max3f(a, s[m][2][2], s[m][2][3]); b = max3f(b, s[m][3][0], s[m][3][1]);
            a = max3f(a, s[m][3][2], s[m][3][3]); a = fmaxf(a, b);
            { auto rr = __builtin_amdgcn_permlane16_swap(__float_as_uint(a), __float_as_uint(a), false, false); a = fmaxf(__uint_as_float(rr[0]), __uint_as_float(rr[1])); }
            { auto rr = __builtin_amdgcn_permlane32_swap(__float_as_uint(a), __float_as_uint(a), false, false); a = fmaxf(__uint_as_float(rr[0]), __uint_as_float(rr[1])); }
            mx[m] = a;
        }
#pragma unroll
        for (int m = 0; m < 2; ++m) { const float d = first ? mx[m] : fmaxf(mx[m], 0.f); const float f = __builtin_amdgcn_exp2f(-d);
#pragma unroll
            for (int c = 0; c < 9; ++c) o[m][c] = o[m][c] * f;
            negm[m] = negm[m] - d;
#pragma unroll
            for (int blk = 0; blk < 4; ++blk) s[m][blk] = s[m][blk] - d; }
    }
#pragma unroll
    for (int m = 0; m < 2; ++m) {
        unsigned pw[8];
#pragma unroll
        for (int blk = 0; blk < 4; ++blk) { const float p0 = __builtin_amdgcn_exp2f(s[m][blk][0]), p1 = __builtin_amdgcn_exp2f(s[m][blk][1]), p2 = __builtin_amdgcn_exp2f(s[m][blk][2]), p3 = __builtin_amdgcn_exp2f(s[m][blk][3]);
            pw[blk * 2] = cvt_pk_bf16(p0, p1); pw[blk * 2 + 1] = cvt_pk_bf16(p2, p3); }
        pf[m][0] = __builtin_bit_cast(bf16x8, (u32x4){pw[0], pw[1], pw[2], pw[3]});
        pf[m][1] = __builtin_bit_cast(bf16x8, (u32x4){pw[4], pw[5], pw[6], pw[7]});
    }
}
template <bool DO_S, bool DO_PV, int AM = 0>
__device__ __forceinline__ void at_stage_x(LAS const unsigned char* Kl, LAS const unsigned char* Vl, const bf16x8 (&qf)[2][2], const f32x4 (&negm)[2], f32x4 (&s)[2][4], const bf16x8 (&pf)[2][2], f32x4 (&o)[2][9]) {
    { unsigned ka = (unsigned)(size_t)Kl; asm volatile("" : "+v"(ka)); Kl = (LAS const unsigned char*)(size_t)ka; }
    { unsigned va = (unsigned)(size_t)Vl; asm volatile("" : "+v"(va)); Vl = (LAS const unsigned char*)(size_t)va; }
    bf16x8 kf[2][4][2]; s16x4 vr[8][2][2];
#define AT_RDV(c) do { _Pragma("unroll") for (int ks_ = 0; ks_ < 2; ++ks_) _Pragma("unroll") for (int t_ = 0; t_ < 2; ++t_) { if constexpr (!(AM & 4)) vr[c][ks_][t_] = tr_read(Vl + 2048 * (c) + 1024 * ks_ + 256 * t_); else { vr[c][ks_][t_] = (s16x4){(short)0x3c11, (short)0xbd22, (short)0x3e33, (short)0xbc44}; asm volatile("" : "+v"(vr[c][ks_][t_])); } } } while (0)
#define AT_PV(c) do { _Pragma("unroll") for (int ks_ = 0; ks_ < 2; ++ks_) { const s16x4 lo_ = vr[c][ks_][0], hi_ = vr[c][ks_][1]; \
        const bf16x8 vf_ = (bf16x8){lo_[0], lo_[1], lo_[2], lo_[3], hi_[0], hi_[1], hi_[2], hi_[3]}; \
        if constexpr (!(AM & 8)) { o[0][c] = __builtin_amdgcn_mfma_f32_16x16x32_bf16(vf_, pf[0][ks_], o[0][c], 0, 0, 0); o[1][c] = __builtin_amdgcn_mfma_f32_16x16x32_bf16(vf_, pf[1][ks_], o[1][c], 0, 0, 0); } else asm volatile("" :: "v"(vf_)); } } while (0)
#define AT_RDK(ds) do { _Pragma("unroll") for (int m_ = 0; m_ < 2; ++m_) _Pragma("unroll") for (int blk_ = 0; blk_ < 4; ++blk_) \
        { if constexpr (!(AM & 4)) kf[m_][blk_][ds] = *(LAS const bf16x8*)(Kl + 4096 * (2 * m_ + (ds)) + 2048 * (blk_ >> 1) + 256 * (blk_ & 1)); else { kf[m_][blk_][ds] = (bf16x8){(short)0x3c11, (short)0xbd22, (short)0x3e33, (short)0xbc44, (short)0x3d55, (short)0xbe66, (short)0x3c77, (short)0xbd88}; asm volatile("" : "+v"(kf[m_][blk_][ds])); } } } while (0)
#define AT_SB() __builtin_amdgcn_sched_barrier(0)
    AT_RDK(0); AT_RDV(0); AT_RDV(1); AT_SB();
    __builtin_amdgcn_s_setprio(1);
    {
        const short one = (short)0x3F80; const bf16x8 vones = (bf16x8){one, one, one, one, one, one, one, one};
#pragma unroll
        for (int ks = 0; ks < 2; ++ks) if constexpr (!(AM & 8)) { o[0][8] = __builtin_amdgcn_mfma_f32_16x16x32_bf16(vones, pf[0][ks], o[0][8], 0, 0, 0); o[1][8] = __builtin_amdgcn_mfma_f32_16x16x32_bf16(vones, pf[1][ks], o[1][8], 0, 0, 0); }
    }
#pragma unroll
    for (int m = 0; m < 2; ++m)
#pragma unroll
        for (int blk = 0; blk < 4; ++blk) { if constexpr (!(AM & 8)) s[m][blk] = __builtin_amdgcn_mfma_f32_16x16x32_bf16(kf[m][blk][0], qf[m][0], negm[m], 0, 0, 0); else asm volatile("" :: "v"(kf[m][blk][0])); }
    AT_SB(); AT_RDK(1); AT_RDV(2); AT_RDV(3); AT_SB();
    AT_PV(0); AT_PV(1); AT_SB();
#pragma unroll
    for (int m = 0; m < 2; ++m)
#pragma unroll
        for (int blk = 0; blk < 4; ++blk) { if constexpr (!(AM & 8)) s[m][blk] = __builtin_amdgcn_mfma_f32_16x16x32_bf16(kf[m][blk][1], qf[m][1], s[m][blk], 0, 0, 0); else asm volatile("" :: "v"(kf[m][blk][1])); }
    AT_SB(); AT_RDV(4); AT_RDV(5); AT_SB();
    AT_PV(2); AT_PV(3); AT_SB();
    AT_RDV(6); AT_RDV(7); AT_SB();
    AT_PV(4); AT_PV(5); AT_SB();
    AT_PV(6); AT_PV(7);
    __builtin_amdgcn_s_setprio(0);
#undef AT_RDK
#undef AT_SB
#undef AT_RDV
#undef AT_PV
}
template <int AM = 0>
__device__ __forceinline__ void attn_unit(const Frame& F, int b, int h, int qb, float lam, const float* subg, bool first_u = true, bool next_u = false) {
    int lane = F.lane; asm volatile("" : "+v"(lane));
    const int wid = F.wave, ql = lane & 15, g = lane >> 4, half = wid >> 2;
    const bf16_t* Qb = (const bf16_t*)(F.ws + WS_U) + 2 * PBUF_STRIDE; const bf16_t* Kb = Qb + PBUF_STRIDE; const bf16_t* Vb = Kb + PBUF_STRIDE; bf16_t* MIX = (bf16_t*)(F.ws + WS_MIX);
    const size_t tokb = (size_t)b * SEQ; const int q0 = qb * 128;
    const int cw = 2 * qb + half;
    const int NT = 2 * qb + 2;
    const size_t qtok = tokb + q0 + 16 * wid + ql;
    const char* Kg = (const char*)Kb + ((size_t)(b * 4 + h) * 128) * 16384;
    const char* Vg = (const char*)Vb + ((size_t)(b * 4 + h) * 128) * 16384;
    const unsigned dvo = (2 * wid) * 1024 + lane * 16;
    const unsigned ldsb = (unsigned)(size_t)F.lds + (2 * wid) * 1024;
#define AT_DMA1(Xg, XOFF, t) do { if constexpr (AM & 16) break; const char* _tb = Xg + (size_t)(t) * 16384; const unsigned _sl = (unsigned)((t) & 3) * AT_SLOT; \
        glds16p(_tb, dvo, (unsigned)__builtin_amdgcn_readfirstlane(ldsb + XOFF + _sl)); } while (0)
    float kmv = 0.f;
    if (first_u && F.tid < 256) { const f32x2 kp = ((const f32x2*)(F.ws + WS_KMAX))[(b * 4 + h) * 256 + F.tid]; kmv = sqrtf(kp.x + kp.y) * 1.01f; }
    if (first_u) { AT_DMA1(Kg, AT_K, 0); AT_DMA1(Kg, AT_K, 1); AT_DMA1(Vg, AT_V, 0); }
    bf16x8 qf[2][2];
#pragma unroll
    for (int m = 0; m < 2; ++m)
#pragma unroll
        for (int ds = 0; ds < 2; ++ds) qf[m][ds] = *(const bf16x8*)(Qb + qtok * 512 + h * 128 + m * 64 + 32 * ds + 8 * g);
    float qn[2];
#pragma unroll
    for (int m = 0; m < 2; ++m) { float a = 0.f;
#pragma unroll
        for (int ds = 0; ds < 2; ++ds) { const u32x4 w = __builtin_bit_cast(u32x4, qf[m][ds]);
            a += bf_lo(w.x) * bf_lo(w.x) + bf_hi(w.x) * bf_hi(w.x) + bf_lo(w.y) * bf_lo(w.y) + bf_hi(w.y) * bf_hi(w.y) + bf_lo(w.z) * bf_lo(w.z) + bf_hi(w.z) * bf_hi(w.z) + bf_lo(w.w) * bf_lo(w.w) + bf_hi(w.w) * bf_hi(w.w); }
        a += __shfl_xor(a, 16); a += __shfl_xor(a, 32); qn[m] = sqrtf(a) * 1.01f; }
    LAS float* kmx = (LAS float*)(F.lds + L_MISC);
    if (first_u && F.tid < 256) kmx[F.tid] = kmv;
    const float bmaxv = ((const LAS float*)(F.lds + L_TBL))[h * 256 + 255];
    f32x4 o[2][9];
#pragma unroll
    for (int m = 0; m < 2; ++m)
#pragma unroll
        for (int c = 0; c < 9; ++c) o[m][c] = (f32x4){0.f, 0.f, 0.f, 0.f};
    f32x4 negm[2] = {(f32x4){0.f, 0.f, 0.f, 0.f}, (f32x4){0.f, 0.f, 0.f, 0.f}};
    f32x4 s[2][4];
    bf16x8 pf[2][2];
#pragma unroll
    for (int m = 0; m < 2; ++m) {
#pragma unroll
        for (int ks = 0; ks < 2; ++ks) { pf[m][ks] = (bf16x8){0, 0, 0, 0, 0, 0, 0, 0}; if constexpr (AM & 1) { pf[m][ks] = (bf16x8){(short)0x3c11, (short)0x3d22, (short)0x3e33, (short)0x3c44, (short)0x3d55, (short)0x3e66, (short)0x3c77, (short)0x3d88}; asm volatile("" : "+v"(pf[m][ks])); } }
#pragma unroll
        for (int blk = 0; blk < 4; ++blk) s[m][blk] = (f32x4){0.f, 0.f, 0.f, 0.f}; }
    const LAS float* tbl = (const LAS float*)(F.lds + L_TBL) + h * 256;
    const int qpos = (16 * wid + ql) & 63;
    const unsigned qh = ql >> 2, p4 = lane & 3u;
    const unsigned kl = 64u * (8u * qh + (ql & 3u)) + 16u * ((unsigned)g ^ ((0x78u >> (2u * qh)) & 3u));
    const unsigned vl = 32u * (qh + 4u * (g & 1) + 16u * (g >> 1)) + 8u * p4;
    asm volatile("" :: "v"(qf[0][0]), "v"(qf[0][1]), "v"(qf[1][0]), "v"(qf[1][1]));
    if (first_u) { asm volatile("s_waitcnt vmcnt(0) lgkmcnt(0)" ::: "memory"); RAW_BAR(); }
#define IT_BEGIN(j) do { if (2 * (j) + 2 <= NT - 1) AT_DMA1(Kg, AT_K, 2 * (j) + 2); if (2 * (j) + 3 <= NT - 1) AT_DMA1(Kg, AT_K, 2 * (j) + 3); \
                         if (2 * (j) + 1 <= NT - 1) AT_DMA1(Vg, AT_V, 2 * (j) + 1); if (2 * (j) + 2 <= NT - 1) AT_DMA1(Vg, AT_V, 2 * (j) + 2); } while (0)
#define IT_END(j) do { asm volatile("s_waitcnt vmcnt(0) lgkmcnt(0)" ::: "memory"); RAW_BAR(); } while (0)
#define KSL(t) (F.lds + AT_K + ((t) & 3) * AT_SLOT + kl)
#define VSL(t) (F.lds + AT_V + ((t) & 3) * AT_SLOT + vl)
#define ST_Y(t) if constexpr (!(AM & 1)) { const bool nr_ = (t) >= cw - 2; const float ba_ = nr_ ? bmaxv : 0.f; at_stage_y(s, tbl, nr_, 64 * ((t) - cw + 2) + 63 - qpos + 8 * g, (t) == 0, qn[0] * kmx[2 * (t)] + ba_, qn[1] * kmx[2 * (t) + 1] + ba_, o, negm, pf); }
#define ST_X(t) do { const int t_ = (t); if constexpr (!(AM & 2)) if (t_ <= cw) at_stage_x<true, true, AM>(KSL(t_ + 1), VSL(t_ < 0 ? 0 : t_), qf, negm, s, pf, o); } while (0)
    auto unit_epilogue = [&]() __attribute__((always_inline)) {
    f32x4 gsub[8];
#pragma unroll
    for (int c = 0; c < 8; ++c) gsub[c] = *(const f32x4*)(subg + 16 * c + 4 * g);
    const float l1 = o[0][8][0], l2 = o[1][8][0];
    const float i1 = __builtin_amdgcn_rcpf(l1), i2 = lam * __builtin_amdgcn_rcpf(l2);
    float ss = 0.f;
#pragma unroll
    for (int c = 0; c < 8; ++c) { o[0][c] = o[0][c] * i1 - o[1][c] * i2; ss += (o[0][c][0] * o[0][c][0] + o[0][c][1] * o[0][c][1]) + (o[0][c][2] * o[0][c][2] + o[0][c][3] * o[0][c][3]); }
    ss += __shfl_xor(ss, 16); ss += __shfl_xor(ss, 32);
    const float rstd = __builtin_amdgcn_rsqf(ss * (1.f / 128.f) + NORM_EPS) * 0.8f;
    bf16_t* op = MIX + qtok * 1024 + 512 + h * 128 + 4 * g;
#pragma unroll
    for (int c = 0; c < 8; ++c) { const f32x4 gg = gsub[c];
        u32x2 w; w.x = cvt_pk_bf16(o[0][c][0] * rstd * gg.x, o[0][c][1] * rstd * gg.y); w.y = cvt_pk_bf16(o[0][c][2] * rstd * gg.z, o[0][c][3] * rstd * gg.w);
        if constexpr (AM == 0) *(u32x2*)(op + 16 * c) = w; else asm volatile("" :: "v"(w)); }
    };
#define IT_NEXT(j) do { if (next_u && 2 * (j) == NT) { AT_DMA1(Kg, AT_K, 0); AT_DMA1(Kg, AT_K, 1); AT_DMA1(Vg, AT_V, 0); } } while (0)
    if (half == 0) {
        for (int j = 0; 2 * j <= NT; ++j) { IT_NEXT(j); ST_X(2 * j - 1); IT_BEGIN(j); if (2 * j <= cw) ST_Y(2 * j); ST_X(2 * j); if (2 * j + 1 <= cw) ST_Y(2 * j + 1); if (2 * j == NT) unit_epilogue(); IT_END(j); }
    } else {
        for (int j = 0; 2 * j <= NT; ++j) { IT_NEXT(j); IT_BEGIN(j); if (j >= 1 && 2 * j - 1 <= cw) ST_Y(2 * j - 1); ST_X(2 * j - 1); if (2 * j <= cw) ST_Y(2 * j); ST_X(2 * j); IT_END(j); }
    }
#undef IT_NEXT
#undef IT_BEGIN
#undef IT_END
#undef KSL
#undef VSL
#undef ST_Y
#undef ST_X
#undef AT_DMA1
    if (half == 1) unit_epilogue();
}

template <int AM = 0>
__device__ __forceinline__ void phase2(const Frame& F, const Args& A, bool do_sgu, bool do_attn) {
#ifndef NO_SGU
    if (do_sgu) {
        for (int u = F.bid; u < 512; u += F.G) sgu_unit(F, A, u);
    }
#endif
#ifndef NO_ATTN
    if (do_attn) {
        LAS float* tbl = (LAS float*)(F.lds + L_TBL); const float* gt = (const float*)(F.ws + WS_TBL);
        for (int i = F.tid; i < 1024; i += NTHR) tbl[i] = gt[i];
        __syncthreads();
        if (F.wave < 4) { float mxb = 0.f;
#pragma unroll
            for (int j = 0; j < 4; ++j) { const int i = F.lane + 64 * j; mxb = fmaxf(mxb, i < 255 ? tbl[F.wave * 256 + i] : 0.f); }
#pragma unroll
            for (int o = 1; o < 64; o <<= 1) mxb = fmaxf(mxb, __shfl_xor(mxb, o));
            if (F.lane == 0) tbl[F.wave * 256 + 255] = mxb; }
        float lam;
        { const float a = F.lane < 64 ? A.in[9][F.lane] * A.in[10][F.lane] : 0.f, b2 = A.in[11][F.lane] * A.in[12][F.lane];
          lam = __expf(wave_sum(a)) - __expf(wave_sum(b2)) + 0.2f; }
        __syncthreads();
        const int vcu = (F.G % 8 == 0) ? (F.bid % 8) * (F.G / 8) + F.bid / 8 : F.bid;
        for (int v = vcu; v < 256; v += F.G) {
            const int bh = v >> 3, s = v & 7;
            for (int i = 0; i < 8; ++i) { const int qb = (i & 1) ? (16 * (i >> 1) + 15 - s) : (16 * (i >> 1) + s);
                attn_unit<AM>(F, bh >> 2, bh & 3, 63 - qb, lam, A.in[13], i == 0, i < 7); }
        }
    }
#endif
}

__device__ __forceinline__ unsigned long long shfl_xor_u64(unsigned long long v, int m) { const unsigned lo = __shfl_xor((unsigned)v, m), hi = __shfl_xor((unsigned)(v >> 32), m); return ((unsigned long long)hi << 32) | lo; }
__device__ __forceinline__ void phase4(const Frame& F, const Args& A) {
    const int lane = F.lane, tl = lane & 15, g = lane >> 4;
    { const u32x4* WH = (const u32x4*)(F.ws + WS_WRH);
      u32x4 t[16];
#pragma unroll
      for (int j = 0; j < 16; ++j) t[j] = WH[F.tid + NTHR * j];
#pragma unroll
      for (int j = 0; j < 16; ++j) { const int i = F.tid + NTHR * j; const int hl = i >> 12, e = (i >> 7) & 31, c = i & 127; *(LAS u32x4*)(F.lds + hl * 65536 + e * 2048 + ((c ^ (e & 15)) * 16)) = t[j]; } }
    LAS int* hist = (LAS int*)(F.lds + L_MISC);
    if (F.tid < 32) hist[F.tid] = 0;
    __syncthreads();
    const float* X = A.in[0]; const bf16_t* D = (const bf16_t*)A.out; bf16_t* H2 = (bf16_t*)(F.ws + WS_H2); float* TG = (float*)(F.ws + WS_TOPG);
    const float* rb = A.in[17]; int* LISTX = (int*)(F.ws + WS_LISTX); float* RSSX = (float*)(F.ws + WS_RSSX);
    const int gw = F.bid * NWAVES + F.wave, NGW = F.G * NWAVES;
    float rbv[8];
#pragma unroll
    for (int j = 0; j < 8; ++j) rbv[j] = rb[16 * (j >> 2) + 4 * g + (j & 3)];
    const bool local = F.G == NTOK / 256;
    const int task0 = local ? F.bid * 16 + F.wave : gw, tstep = local ? NWAVES : NGW, tend = local ? F.bid * 16 + 16 : NTOK / 16;
    for (int task = task0; task < tend; task += tstep) {
        const int tok = task * 16 + tl;
        const float* xr = X + (size_t)tok * DM + 8 * g;
        const bf16_t* dr = D + (size_t)tok * 2048 + 8 * g;
        bf16_t* dw = (bf16_t*)A.out + (size_t)tok * 2048 + 8 * g;
        unsigned char* hr = (unsigned char*)H2 + (size_t)tok * DM + 8 * g;
        f32x4 acc[2] = {(f32x4){0.f, 0.f, 0.f, 0.f}, (f32x4){0.f, 0.f, 0.f, 0.f}}; float ssq = 0.f;
#pragma unroll 1
        for (int kq = 0; kq < 4; ++kq) {
            u32x2 hbuf[8]; f32x4 xa[8], xb[8]; u32x4 xd[8];
#pragma unroll
            for (int k8 = 0; k8 < 8; ++k8) { const int ks = kq * 8 + k8; xa[k8] = *(const f32x4*)(xr + 32 * ks); xb[k8] = *(const f32x4*)(xr + 32 * ks + 4); xd[k8] = *(const u32x4*)(dr + 32 * ks); }
            __builtin_amdgcn_sched_barrier(0);
#pragma unroll
            for (int k8 = 0; k8 < 8; ++k8) { const int ks = kq * 8 + k8;
                f32x4 a = xa[k8], b = xb[k8];
                a.x += bf_lo(xd[k8].x); a.y += bf_hi(xd[k8].x); a.z += bf_lo(xd[k8].y); a.w += bf_hi(xd[k8].y); b.x += bf_lo(xd[k8].z); b.y += bf_hi(xd[k8].z); b.z += bf_lo(xd[k8].w); b.w += bf_hi(xd[k8].w);
                ssq += (a.x * a.x + a.y * a.y) + (a.z * a.z + a.w * a.w) + (b.x * b.x + b.y * b.y) + (b.z * b.z + b.w * b.w);
                u32x4 hi; hi.x = cvt_pk_bf16(a.x, a.y); hi.y = cvt_pk_bf16(a.z, a.w); hi.z = cvt_pk_bf16(b.x, b.y); hi.w = cvt_pk_bf16(b.z, b.w);
                xd[k8] = hi;
                u32x4 lo; lo.x = cvt_pk_bf16(a.x - bf_lo(hi.x), a.y - bf_hi(hi.x)); lo.y = cvt_pk_bf16(a.z - bf_lo(hi.y), a.w - bf_hi(hi.y));
                lo.z = cvt_pk_bf16(b.x - bf_lo(hi.z), b.y - bf_hi(hi.z)); lo.w = cvt_pk_bf16(b.z - bf_lo(hi.w), b.w - bf_hi(hi.w));
                hbuf[k8] = (u32x2){cvt4_fp8(a.x * F8_XSCALE, a.y * F8_XSCALE, a.z * F8_XSCALE, a.w * F8_XSCALE), cvt4_fp8(b.x * F8_XSCALE, b.y * F8_XSCALE, b.z * F8_XSCALE, b.w * F8_XSCALE)};
                const bf16x8 xh = __builtin_bit_cast(bf16x8, hi), xl = __builtin_bit_cast(bf16x8, lo);
#pragma unroll
                for (int nb = 0; nb < 2; ++nb) { const int e = 16 * nb + tl; const unsigned co = e * 2048 + (((4 * ks + g) ^ (e & 15)) * 16);
                    const bf16x8 wh = *(LAS const bf16x8*)(F.lds + co), wl = *(LAS const bf16x8*)(F.lds + 65536 + co);
                    acc[nb] = __builtin_amdgcn_mfma_f32_16x16x32_bf16(wh, xh, acc[nb], 0, 0, 0);
                    acc[nb] = __builtin_amdgcn_mfma_f32_16x16x32_bf16(wh, xl, acc[nb], 0, 0, 0);
                    acc[nb] = __builtin_amdgcn_mfma_f32_16x16x32_bf16(wl, xh, acc[nb], 0, 0, 0); }
            }
#pragma unroll
            for (int k8 = 0; k8 < 8; ++k8) { *(u32x2*)(hr + 32 * (kq * 8 + k8)) = hbuf[k8]; *(u32x4*)(dw + 32 * (kq * 8 + k8)) = xd[k8]; }
        }
        ssq += __shfl_xor(ssq, 16); ssq += __shfl_xor(ssq, 32);
        const float rstd = __builtin_amdgcn_rsqf(ssq * (1.f / DM) + NORM_EPS);
        unsigned long long key[8];
#pragma unroll
        for (int nb = 0; nb < 2; ++nb)
#pragma unroll
            for (int r = 0; r < 4; ++r) { const int e = 16 * nb + 4 * g + r; const float v = acc[nb][r] * rstd + rbv[nb * 4 + r];
                unsigned u = __float_as_uint(v); u = (u & 0x80000000u) ? ~u : (u | 0x80000000u); key[nb * 4 + r] = ((unsigned long long)u << 32) | (unsigned)(31 - e); }
        unsigned long long best[4];
#pragma unroll
        for (int rnd = 0; rnd < 4; ++rnd) {
            unsigned long long bk = key[0];
#pragma unroll
            for (int j = 1; j < 8; ++j) bk = key[j] > bk ? key[j] : bk;
            unsigned long long o1 = shfl_xor_u64(bk, 16); bk = o1 > bk ? o1 : bk; o1 = shfl_xor_u64(bk, 32); bk = o1 > bk ? o1 : bk;
            best[rnd] = bk;
#pragma unroll
            for (int j = 0; j < 8; ++j) key[j] = (key[j] == bk) ? 0ull : key[j];
        }
        float tv[4]; int te[4];
#pragma unroll
        for (int j = 0; j < 4; ++j) { unsigned u = (unsigned)(best[j] >> 32); u = (u & 0x80000000u) ? (u & 0x7fffffffu) : ~u; tv[j] = __uint_as_float(u); te[j] = 31 - (int)(best[j] & 0xffffffffu); }
        const float e1 = __expf(tv[1] - tv[0]), e2 = __expf(tv[2] - tv[0]), e3 = __expf(tv[3] - tv[0]); const float inv = 1.0f / (1.0f + e1 + e2 + e3);
        const float gate = (g == 0 ? 1.0f : g == 1 ? e1 : g == 2 ? e2 : e3) * inv; const int ee = g == 0 ? te[0] : g == 1 ? te[1] : g == 2 ? te[2] : te[3];
        TG[tok * 4 + g] = gate;
        const int li = __hip_atomic_fetch_add(&hist[ee], 1, __ATOMIC_RELAXED, __HIP_MEMORY_SCOPE_WORKGROUP);
        __syncthreads();
        if (F.tid < 32) { const int c = hist[F.tid]; hist[32 + F.tid] = c ? (int)atomicAdd(F.ctl + CW_CUR + F.tid, (unsigned)c) : 0; }
        __syncthreads();
        { const int pos = ee * LCAP + hist[32 + ee] + li; LISTX[pos] = tok * 4 + g; RSSX[pos] = rstd; }
        __syncthreads();
        if (F.tid < 32) hist[F.tid] = 0;
        __syncthreads();
    }
}

__device__ __forceinline__ void phase8(const Frame& F, const Args& A) {
    int lane = F.lane; asm volatile("" : "+v"(lane));
    const int gw = F.bid * NWAVES + F.wave, NGW = F.G * NWAVES;
    const bf16_t* Y = (const bf16_t*)(F.ws + WS_Y); const float* TG = (const float*)(F.ws + WS_TOPG);
    const f32x4* gq = (const f32x4*)A.in[22] + lane;
    f32x4 gv[4];
#pragma unroll
    for (int j = 0; j < 4; ++j) gv[j] = gq[64 * j];
    for (int m = gw; m < NTOK; m += NGW) {
        const int tok = m;
        f32x4* xr = (f32x4*)(A.out + (size_t)tok * DM) + lane;
        const u32x2* dq = (const u32x2*)((const bf16_t*)A.out + (size_t)tok * 2048) + lane;
        const f32x4 gt = *(const f32x4*)(TG + tok * 4);
        f32x4 v[4];
#pragma unroll
        for (int j = 0; j < 4; ++j) { const u32x2 dw = dq[64 * j]; v[j] = (f32x4){bf_lo(dw.x), bf_hi(dw.x), bf_lo(dw.y), bf_hi(dw.y)}; }
#pragma unroll
        for (int k = 0; k < 4; ++k) { const unsigned* yr = (const unsigned*)((const unsigned char*)Y + ((size_t)m * 4 + k) * DM) + lane; const float gk = gt[k] * (1.0f / F8_YSCALE);
#pragma unroll
            for (int j = 0; j < 4; ++j) { const int w = (int)yr[64 * j]; const f32x2 lo = __builtin_amdgcn_cvt_pk_f32_fp8(w, false), hi = __builtin_amdgcn_cvt_pk_f32_fp8(w, true);
                v[j].x += gk * lo.x; v[j].y += gk * lo.y; v[j].z += gk * hi.x; v[j].w += gk * hi.y; } }
        float s = 0.f;
#pragma unroll
        for (int j = 0; j < 4; ++j) s += (v[j].x * v[j].x + v[j].y * v[j].y) + (v[j].z * v[j].z + v[j].w * v[j].w);
        const float rstd = __builtin_amdgcn_rsqf(wave_sum(s) * (1.f / DM) + NORM_EPS);
#pragma unroll
        for (int j = 0; j < 4; ++j) xr[64 * j] = v[j] * rstd * gv[j];
    }
}

constexpr int N_PHASES = 10;
__global__ void __launch_bounds__(NTHR, 2) mk_fwd(Args args) {
    extern __shared__ __attribute__((aligned(16))) unsigned char lds_raw[];
    Frame F;
    F.lds = (LAS unsigned char*)lds_raw; F.ws = args.ws; F.ctl = (unsigned*)(args.ws + WS_CTL);
    F.tid = threadIdx.x; F.lane = F.tid & 63; F.wave = __builtin_amdgcn_readfirstlane(F.tid >> 6); F.G = gridDim.x; F.bid = blockIdx.x;
    if (F.tid < 64) ((LAS unsigned*)(F.lds + L_CTL))[F.tid] = 0u;
    __syncthreads();
    const int lo = args.ph_lo, hi = args.ph_hi;
    XcdBarrier bar; bar.bar = F.ctl + CW_BAR; bar.x = 0; bar.st = (volatile LAS unsigned*)(F.lds + L_CTL);
    if (hi - lo > 1) bar = xcd_barrier_post(F.ctl + CW_BAR, (volatile LAS unsigned*)(F.lds + L_CTL));
#ifdef ONLY_PHASE
#define IN(k) ((k) == ONLY_PHASE && lo <= (k) && (k) < hi)
#else
#define IN(k) (lo <= (k) && (k) < hi)
#endif
#define SEAM(k) do { if (IN(k) && IN((k) + 1)) xcd_barrier(bar); } while (0)

    if (IN(0)) { phase0(F, args); } SEAM(0);
    if (IN(1)) { InProj P{(const bf16_t*)(F.ws + WS_H), (const bf16_t*)(F.ws + WS_WIN), (bf16_t*)(F.ws + WS_U), (float*)(F.ws + WS_KMAX), F.G, F.bid}; pg::gemm_phase<InProj>(F.lds, P); } SEAM(1);
    if (IN(3)) { phase2(F, args, true, true); } SEAM(3);
    if (IN(4)) { OutProj P{(const bf16_t*)(F.ws + WS_MIX), (const bf16_t*)(F.ws + WS_WOUT), (bf16_t*)args.out, F.G, F.bid}; pg::gemm_phase<OutProj>(F.lds, P); }
    if (IN(4) && IN(5)) { if (F.G == NTOK / 256) { asm volatile("s_waitcnt vmcnt(0)" ::: "memory"); __syncthreads(); __builtin_amdgcn_fence(__ATOMIC_ACQUIRE, "workgroup"); }
                          else xcd_barrier(bar); }
    if (IN(5)) { phase4(F, args); } SEAM(5);
    if (IN(7)) { moe_tables(F);
        Moe1 P{(const bf16_t*)(F.ws + WS_H2), (const bf16_t*)(F.ws + WS_W1), args.in[19], (bf16_t*)(F.ws + WS_ACT), (const int*)(F.ws + WS_LISTX), (const float*)(F.ws + WS_RSSX),
               (const LAS int*)(F.lds + L_MISC), (const LAS int*)(F.lds + L_MISC) + 64, F.G, F.bid};
        pg::gemm_phase<Moe1>(F.lds, P); }
    SEAM(7);
    if (IN(8)) { moe_tables(F);
        Moe2 P{(const bf16_t*)(F.ws + WS_ACT), (const bf16_t*)(F.ws + WS_W2), args.in[21], (bf16_t*)(F.ws + WS_Y), (const int*)(F.ws + WS_LISTX), 0,
               (const LAS int*)(F.lds + L_MISC), (const LAS int*)(F.lds + L_MISC) + 64, F.G, F.bid};
        pg::gemm_phase<Moe2>(F.lds, P); }
    SEAM(8);
    if (IN(9)) { phase8(F, args); }
#if PROBE_AMODE >= 0
    if (IN(11)) { phase2<PROBE_AMODE>(F, args, false, true); }
#endif
#if PROBE_MODE >= 0
    if (IN(10)) { moe_tables(F);
        Moe2 P{(const bf16_t*)(F.ws + WS_ACT), (const bf16_t*)(F.ws + WS_W2), args.in[21], (bf16_t*)(F.ws + WS_Y), (const int*)(F.ws + WS_LISTX), 0,
               (const LAS int*)(F.lds + L_MISC), (const LAS int*)(F.lds + L_MISC) + 64, F.G, F.bid};
        pg::gemm_phase<Moe2, PROBE_MODE>(F.lds, P); }
#endif
#undef IN
#undef SEAM
}

extern "C" void kernel_launch(void* const* d_in, const int* in_sizes, int n_in, void* d_out, int out_size, void* d_ws, size_t ws_size, hipStream_t stream) {
    static int grid = 0;
    if (grid == 0) {
        if (n_in != 23 || in_sizes[0] != NTOK * DM || out_size != NTOK * DM || ws_size < WS_END) { fprintf(stderr, "kernel_launch: unexpected shapes (n_in %d, ws %zu); nothing launched\n", n_in, ws_size); grid = -1; return; }
        int dev = 0, cus = 0, per_cu = 0;
        if (hipGetDevice(&dev) != hipSuccess || hipDeviceGetAttribute(&cus, hipDeviceAttributeMultiprocessorCount, dev) != hipSuccess) { grid = -1; return; }
        if (hipFuncSetAttribute((const void*)mk_fwd, hipFuncAttributeMaxDynamicSharedMemorySize, LDS_BYTES) != hipSuccess) { fprintf(stderr, "kernel_launch: hipFuncSetAttribute failed\n"); grid = -1; return; }
        if (hipOccupancyMaxActiveBlocksPerMultiprocessor(&per_cu, (const void*)mk_fwd, NTHR, LDS_BYTES) != hipSuccess || per_cu < 1) { fprintf(stderr, "kernel_launch: occupancy query says %d\n", per_cu); }
        (void)hipGetLastError();
        grid = cus;
    }
    if (grid < 0) return;
    (void)hipMemsetAsync((char*)d_ws + WS_CTL, 0, CTL_ZERO_BYTES, stream);
    Args a{};
    for (int i = 0; i < 23; ++i) a.in[i] = (const float*)d_in[i];
    a.out = (float*)d_out; a.ws = (unsigned char*)d_ws;
#if MK_N_LAUNCHES == 1
    a.ph_lo = 0; a.ph_hi = N_PHASES;
    hipLaunchKernelGGL(mk_fwd, dim3(grid), dim3(NTHR), LDS_BYTES, stream, a);
#else
    for (int p = 0; p < N_PHASES; ++p) { a.ph_lo = p; a.ph_hi = p + 1; const int nrep = (p == PROBE_REPEAT) ? 2 : 1;
        for (int r = 0; r < nrep; ++r) hipLaunchKernelGGL(mk_fwd, dim3(grid), dim3(NTHR), LDS_BYTES, stream, a);
#if PROBE_AMODE >= 0
        if (p == 3) { a.ph_lo = 11; a.ph_hi = 12; hipLaunchKernelGGL(mk_fwd, dim3(grid), dim3(NTHR), LDS_BYTES, stream, a); }
#endif
#if PROBE_MODE >= 0
        if (p == 8) { a.ph_lo = 10; a.ph_hi = 11; hipLaunchKernelGGL(mk_fwd, dim3(grid), dim3(NTHR), LDS_BYTES, stream, a); }
#endif
    }
#endif
}
```
